# Optimizing an MI355X kernel written in HIP

```python
import math
import jax, jax.numpy as jnp
from jax import lax
import numpy as np

D_MODEL = 1024
BATCH = 8
SEQ = 4096
DEPTH = 2

N_META = 16
D_CONV = D_MODEL // 2
CONV_WIDTH = 3
D_ATTN = D_MODEL - D_CONV
ATTN_HEAD_DIM = 64
N_ATTN_HEADS = D_ATTN // (2 * ATTN_HEAD_DIM)
QK_W = N_ATTN_HEADS * 2 * ATTN_HEAD_DIM
V_W = N_ATTN_HEADS * 2 * ATTN_HEAD_DIM
D_IN = 3 * D_CONV + 2 * QK_W + V_W
ROPE_THETA = 10000.0
Q_BLOCK = 128
D_FF_DENSE = 2816
N_EXPERTS = 8
TOP_K = 2
D_FF_EXPERT = 3584
N_DENSE_LAYERS = (DEPTH + 1) // 2
N_MOE_LAYERS = DEPTH // 2
LN_EPS = 1e-5
RMS_EPS = 1e-5
DEEPNORM_ALPHA = (2 * DEPTH) ** 0.25
DEEPNORM_BETA = (8 * DEPTH) ** -0.25

kernel_name = 'hybrid_conv_diffattn_deepnorm_moe'


def layer_norm(x, g, b):
    xf = x.astype(jnp.float32)
    mu = jnp.mean(xf, axis=-1, keepdims=True)
    xc = xf - mu
    var = jnp.mean(xc * xc, axis=-1, keepdims=True)
    y = xc * lax.rsqrt(var + LN_EPS) * g.astype(jnp.float32) + b.astype(jnp.float32)
    return y.astype(x.dtype)


def rms_norm(x, g):
    xf = x.astype(jnp.float32)
    y = xf * lax.rsqrt(jnp.mean(xf * xf, axis=-1, keepdims=True) + RMS_EPS) * g.astype(jnp.float32)
    return y.astype(x.dtype)


def rope_tables(length):
    inv = 1.0 / (ROPE_THETA ** (jnp.arange(0, ATTN_HEAD_DIM, 2, dtype=jnp.float32) / ATTN_HEAD_DIM))
    ang = jnp.arange(length, dtype=jnp.float32)[:, None] * inv[None, :]
    ang = jnp.concatenate([ang, ang], axis=-1)
    return jnp.cos(ang), jnp.sin(ang)


def apply_rope(x, cos, sin):
    c = cos[None, :, None, None, :].astype(x.dtype)
    s = sin[None, :, None, None, :].astype(x.dtype)
    x1, x2 = jnp.split(x, 2, axis=-1)
    return x * c + jnp.concatenate([-x2, x1], axis=-1) * s


def short_gated_conv(u_b, u_c, u_h, conv_w):
    v = u_c * u_h
    y = lax.conv_general_dilated(
        v, conv_w[:, None, :].astype(v.dtype), window_strides=(1,),
        padding=[(CONV_WIDTH - 1, 0)], dimension_numbers=('NWC', 'WIO', 'NWC'),
        feature_group_count=D_CONV)
    return u_b * y


def diff_attention(q, k, v, lam, lambda_init, subln_g, cos, sin):
    bsz, length = q.shape[0], q.shape[1]
    n_blk = -(-length // Q_BLOCK)
    lp = n_blk * Q_BLOCK
    pad = lp - length
    q = jnp.pad(apply_rope(q, cos, sin), ((0, 0), (0, pad), (0, 0), (0, 0), (0, 0)))
    k = jnp.pad(apply_rope(k, cos, sin), ((0, 0), (0, pad), (0, 0), (0, 0), (0, 0)))
    v = jnp.pad(v, ((0, 0), (0, pad), (0, 0), (0, 0)))
    q_blocks = q.reshape(bsz, n_blk, Q_BLOCK, N_ATTN_HEADS, 2, ATTN_HEAD_DIM).transpose(1, 0, 2, 3, 4, 5)
    kpos = jnp.arange(lp)
    scale = ATTN_HEAD_DIM ** -0.5

    def attend(args):
        qb, blk = args
        s = jnp.einsum('bqhcd,bkhcd->bhcqk', qb, k).astype(jnp.float32) * scale
        qpos = blk * Q_BLOCK + jnp.arange(Q_BLOCK)
        causal = kpos[None, :] <= qpos[:, None]
        p = jax.nn.softmax(jnp.where(causal, s, -jnp.inf), axis=-1)
        a = p[:, :, 0] - lam * p[:, :, 1]
        return jnp.einsum('bhqk,bkhe->bqhe', a.astype(v.dtype), v)

    o = lax.map(attend, (q_blocks, jnp.arange(n_blk)))
    o = o.transpose(1, 0, 2, 3, 4).reshape(bsz, lp, N_ATTN_HEADS, 2 * ATTN_HEAD_DIM)[:, :length]
    o = rms_norm(o, subln_g) * (1.0 - lambda_init)
    return o.reshape(bsz, length, D_ATTN)


def hybrid_mixer(h, w_in, conv_w, lq1, lk1, lq2, lk2, subln_g, w_out, lambda_init, cos, sin):
    bsz, length, _ = h.shape
    z = jnp.einsum('bld,de->ble', h, w_in)
    cuts = [D_CONV, 2 * D_CONV, 3 * D_CONV, 3 * D_CONV + QK_W, 3 * D_CONV + 2 * QK_W]
    u_b, u_c, u_h, q, k, v = jnp.split(z, cuts, axis=-1)
    conv_out = short_gated_conv(u_b, u_c, u_h, conv_w)
    q = q.reshape(bsz, length, N_ATTN_HEADS, 2, ATTN_HEAD_DIM)
    k = k.reshape(bsz, length, N_ATTN_HEADS, 2, ATTN_HEAD_DIM)
    v = v.reshape(bsz, length, N_ATTN_HEADS, 2 * ATTN_HEAD_DIM)
    lam = (jnp.exp(jnp.sum((lq1 * lk1).astype(jnp.float32)))
           - jnp.exp(jnp.sum((lq2 * lk2).astype(jnp.float32))) + lambda_init)
    attn_out = diff_attention(q, k, v, lam, lambda_init, subln_g, cos, sin)
    return jnp.einsum('ble,ed->bld', jnp.concatenate([conv_out, attn_out], axis=-1), w_out)


def swiglu(h, w_gate, w_up, w_down):
    return jnp.matmul(jax.nn.silu(jnp.matmul(h, w_gate)) * jnp.matmul(h, w_up), w_down)


def moe_swiglu(h, w_router, w_gate, w_up, w_down):
    logits = jnp.einsum('bld,de->ble', h, w_router).astype(jnp.float32)
    top_val, top_idx = lax.top_k(logits, TOP_K)
    top_w = jax.nn.softmax(top_val, axis=-1)
    gate = jnp.sum(jax.nn.one_hot(top_idx, N_EXPERTS, dtype=jnp.float32) * top_w[..., None], axis=-2)
    gate = gate.astype(h.dtype)
    out = jnp.zeros_like(h)
    for e in range(N_EXPERTS):
        out = out + gate[..., e:e + 1] * swiglu(h, w_gate[e], w_up[e], w_down[e])
    return out


def setup_inputs(seed: int = 0) -> dict:
    key = jax.random.key(seed)
    ks = jax.random.split(key, 26)
    f32 = jnp.float32

    def nrm(k, shape, s):
        return jax.random.normal(k, shape, f32) * s

    def gain(k, shape):
        return 1.0 + 0.01 * jax.random.normal(k, shape, f32)

    return {
        'x': nrm(ks[0], (BATCH, SEQ, D_MODEL), 1.0),
        'meta_tokens': nrm(ks[1], (N_META, D_MODEL), 1.0),
        'ln_emb_g': gain(ks[2], (D_MODEL,)),
        'ln_emb_b': nrm(ks[3], (D_MODEL,), 0.01),
        'w_in': nrm(ks[4], (DEPTH, D_MODEL, D_IN), D_MODEL ** -0.5),
        'conv_w': nrm(ks[5], (DEPTH, CONV_WIDTH, D_CONV), CONV_WIDTH ** -0.5),
        'lambda_q1': nrm(ks[6], (DEPTH, ATTN_HEAD_DIM), 0.1),
        'lambda_k1': nrm(ks[7], (DEPTH, ATTN_HEAD_DIM), 0.1),
        'lambda_q2': nrm(ks[8], (DEPTH, ATTN_HEAD_DIM), 0.1),
        'lambda_k2': nrm(ks[9], (DEPTH, ATTN_HEAD_DIM), 0.1),
        'subln_g': gain(ks[10], (DEPTH, 2 * ATTN_HEAD_DIM)),
        'w_out': nrm(ks[11], (DEPTH, D_MODEL, D_MODEL), D_MODEL ** -0.5 * DEEPNORM_BETA),
        'ln_mix_g': gain(ks[12], (DEPTH, D_MODEL)),
        'ln_mix_b': nrm(ks[13], (DEPTH, D_MODEL), 0.01),
        'ln_ffn_g': gain(ks[14], (DEPTH, D_MODEL)),
        'ln_ffn_b': nrm(ks[15], (DEPTH, D_MODEL), 0.01),
        'w_gate_dense': nrm(ks[16], (N_DENSE_LAYERS, D_MODEL, D_FF_DENSE), D_MODEL ** -0.5),
        'w_up_dense': nrm(ks[17], (N_DENSE_LAYERS, D_MODEL, D_FF_DENSE), D_MODEL ** -0.5),
        'w_down_dense': nrm(ks[18], (N_DENSE_LAYERS, D_FF_DENSE, D_MODEL), D_FF_DENSE ** -0.5 * DEEPNORM_BETA),
        'w_router': nrm(ks[19], (N_MOE_LAYERS, D_MODEL, N_EXPERTS), D_MODEL ** -0.5),
        'w_gate_moe': nrm(ks[20], (N_MOE_LAYERS, N_EXPERTS, D_MODEL, D_FF_EXPERT), D_MODEL ** -0.5),
        'w_up_moe': nrm(ks[21], (N_MOE_LAYERS, N_EXPERTS, D_MODEL, D_FF_EXPERT), D_MODEL ** -0.5),
        'w_down_moe': nrm(ks[22], (N_MOE_LAYERS, N_EXPERTS, D_FF_EXPERT, D_MODEL), D_FF_EXPERT ** -0.5 * DEEPNORM_BETA),
    }


def reference(x, meta_tokens, ln_emb_g, ln_emb_b, w_in, conv_w, lambda_q1, lambda_k1,
              lambda_q2, lambda_k2, subln_g, w_out, ln_mix_g, ln_mix_b, ln_ffn_g, ln_ffn_b,
              w_gate_dense, w_up_dense, w_down_dense, w_router, w_gate_moe, w_up_moe, w_down_moe):
    bsz = x.shape[0]
    meta = jnp.broadcast_to(meta_tokens[None].astype(x.dtype), (bsz, N_META, D_MODEL))
    h = jnp.concatenate([meta, x], axis=1)
    cos, sin = rope_tables(h.shape[1])
    h = layer_norm(h, ln_emb_g, ln_emb_b)
    for layer in range(DEPTH):
        lambda_init = 0.8 - 0.6 * math.exp(-0.3 * layer)
        mix = hybrid_mixer(h, w_in[layer], conv_w[layer], lambda_q1[layer], lambda_k1[layer],
                           lambda_q2[layer], lambda_k2[layer], subln_g[layer], w_out[layer],
                           lambda_init, cos, sin)
        h = layer_norm(DEEPNORM_ALPHA * h + mix, ln_mix_g[layer], ln_mix_b[layer])
        idx = layer // 2
        if layer % 2 == 0:
            ffn = swiglu(h, w_gate_dense[idx], w_up_dense[idx], w_down_dense[idx])
        else:
            ffn = moe_swiglu(h, w_router[idx], w_gate_moe[idx], w_up_moe[idx], w_down_moe[idx])
        h = layer_norm(DEEPNORM_ALPHA * h + ffn, ln_ffn_g[layer], ln_ffn_b[layer])
    return h[:, N_META:]
```

```cpp
#include <hip/hip_runtime.h>
#include <cstdio>
#include <cstdint>
__device__ __forceinline__ int fresh_tid() { int t = threadIdx.x; asm volatile("" : "+v"(t)); return t; }
#ifndef PROBE_EPI2
#define PROBE_EPI2 0
#endif
namespace pg8 {
#define PG8_LAS __attribute__((address_space(3)))
typedef unsigned short bf16_t;
typedef short bf16x8 __attribute__((ext_vector_type(8)));
typedef float f32x4 __attribute__((ext_vector_type(4)));
typedef unsigned u32x4 __attribute__((ext_vector_type(4)));
typedef int i32x8 __attribute__((ext_vector_type(8)));
constexpr int BM = 256, BK = 64, HALF = 128, HTB = HALF * BK * 2  , STAGE_BYTES = 8 * HTB, NXCD = 8, WGM = 4;

__host__ __device__ __forceinline__ int lds_byte(int r, int c) { const int st = (r >> 4) * 2 + (c >> 5), rr = r & 15, cc = c & 31, ob = rr * 64 + cc * 2; return st * 1024 + (ob ^ (((ob >> 9) & 1) << 5)); }
__host__ __device__ __forceinline__ void stage_rc(int b, int& R, int& C) { const int st = b / 1024, sb = b % 1024, swz = sb ^ (((sb >> 9) & 1) << 5); R = (st >> 1) * 16 + swz / 64; C = (st & 1) * 32 + (swz % 64) / 2; }
__host__ __device__ __forceinline__ int perm32(int rho) { const int n = rho >> 4, i = rho & 15; return 8 * (i >> 2) + 4 * n + (i & 3); }

struct Unit { int pm, pn, pv, pq; };
struct Gemm { const bf16_t* A; const bf16_t* Bt; int M, N, K; const int* gi = nullptr; };

struct StaticOrder {
    int nM, nN, nwg, G, c;
    __host__ __device__ void init(int M, int N, int G_, int c_) { nM = M / BM; nN = N / BM; nwg = nM * nN; G = G_; c = c_; }
    __host__ __device__ bool next(int i, Unit& u) const {
        const long L = (long)i * G + c; if (L >= nwg) return false;
        int wgid = (int)L; { const int q = nwg / NXCD, r = nwg % NXCD, xcd = wgid % NXCD, off = wgid / NXCD; wgid = (xcd < r ? xcd * (q + 1) : r * (q + 1) + (xcd - r) * q) + off; }
        const int nig = WGM * nN, gid = wgid / nig, fm = gid * WGM, gsz = (nM - fm) < WGM ? (nM - fm) : WGM;
        u.pm = fm + ((wgid % nig) % gsz); u.pn = (wgid % nig) / gsz; return true;
    }
    __host__ __device__ bool next_lane(int i, Unit& u) const { return next(i, u); }
    __device__ __forceinline__ void a_ready(const Unit&) const {}
    __device__ __forceinline__ void done(const Unit&) const {}
};

constexpr int UL_OFF = 136192, UL_MAX = 48;
struct ListOrder {
    PG8_LAS unsigned char* ring;
    __device__ __forceinline__ bool next(int i, Unit& u) const {
        if (i >= UL_MAX) return false;
        typedef int i32x4l __attribute__((ext_vector_type(4))); const i32x4l v = *(const PG8_LAS i32x4l*)(ring + UL_OFF + 16 * i); const int a = v.x, b = v.y, c = v.z, d = v.w;
        if (__builtin_amdgcn_readfirstlane(d) == 0) return false;
        u.pm = __builtin_amdgcn_readfirstlane(a); u.pn = __builtin_amdgcn_readfirstlane(b); u.pv = __builtin_amdgcn_readfirstlane(c); u.pq = __builtin_amdgcn_readfirstlane(d) - 1; return true;
    }
    __device__ __forceinline__ void a_ready(const Unit&) const {}
    __device__ __forceinline__ void done(const Unit&) const {}
};
template <class Sched> __device__ __forceinline__ ListOrder make_list(PG8_LAS unsigned char* ring, const Sched& S, int tid) {
    if (tid < UL_MAX) { Unit u; u.pm = 0; u.pn = 0; u.pv = 0; u.pq = 0; const bool ok = S.next_lane(tid, u);
        typedef int i32x4l __attribute__((ext_vector_type(4))); *(PG8_LAS i32x4l*)(ring + UL_OFF + 16 * tid) = (i32x4l){u.pm, u.pn, u.pv, ok ? u.pq + 1 : 0}; }
    __syncthreads();
    ListOrder L; L.ring = ring; return L;
}


__device__ __forceinline__ unsigned cvt_pk_bf16(float lo, float hi) { unsigned r; asm volatile("v_cvt_pk_bf16_f32 %0, %1, %2" : "=v"(r) : "v"(lo), "v"(hi)); return r; }
template <bool FP8> struct FragSel;
template <> struct FragSel<false> { typedef bf16x8 TA; static constexpr int NA = 4, NK = 2;
    static __device__ __forceinline__ f32x4 mma16(bf16x8 b, bf16x8 a, f32x4 c) { return __builtin_amdgcn_mfma_f32_16x16x32_bf16(b, a, c, 0, 0, 0); }
    static __device__ __forceinline__ f32x4 mma8(bf16x8, bf16x8, f32x4 c) { return c; } };
template <> struct FragSel<true> { typedef i32x8 TA; static constexpr int NA = 4, NK = 1;
    static __device__ __forceinline__ f32x4 mma16(i32x8, i32x8, f32x4 c) { return c; }
    static __device__ __forceinline__ f32x4 mma8(i32x8 b, i32x8 a, f32x4 c) { asm volatile("v_mfma_f32_16x16x128_f8f6f4 %0, %1, %2, %0" : "+v"(c) : "v"(b), "v"(a)); return c; } };
constexpr int PG8_GI_OFF = 132096;
template <class Epi, class Sched, bool ALIGN_EPI = false, bool SP2 = false, bool FP8 = false, bool GATHER = false, bool SPLITK = false>
__device__ __forceinline__ void gemm_phase(PG8_LAS unsigned char* lds, const Gemm g, const Sched& S, const Epi& E) {
    const int tid = fresh_tid(), wid = __builtin_amdgcn_readfirstlane(tid >> 6), lane = tid & 63, wr = wid >> 2, wc = wid & 3, fr = lane & 15, fq = lane >> 4;
    const int K = g.K, nt = SPLITK ? g.M : K / BK;
    unsigned voffA[2], voffB[2];
#pragma unroll
    for (int i = 0; i < 2; ++i) { int R, C; stage_rc(tid * 16 + i * 8192, R, C); const int Rb = Epi::PERM ? ((R & ~31) + perm32(R & 31)) : R;
        voffA[i] = (unsigned)(R * K + C) * 2u; voffB[i] = (unsigned)(Rb * K + C) * 2u; }
    unsigned goC[2][2], goN[2][2];
    (void)goC; (void)goN;
    const size_t kstep = (size_t)(BK * 2);
    const size_t hstep = (size_t)HALF * K * 2;
    const size_t tstep = 2 * hstep;
    const unsigned ldsw = (unsigned)wid * 1024u;
    const int aoff = lds_byte(wr * 64 + fr, fq * 8), boff = lds_byte(wc * 32 + fr, fq * 8);
#define PG8_SA(b, h) (((b) * 2 + (h)) * HTB)
#define PG8_SB(b, h) ((4 + (b) * 2 + (h)) * HTB)
#define PG8_STAGE_A(bufoff, kptr, h, go) do { if constexpr (GATHER) PG8_STAGE(bufoff, kptr, go[h]); else PG8_STAGE(bufoff, (kptr) + (h) * hstep, voffA); } while (0)
#define PG8_STAGE(bufoff, gbase, voff) do { _Pragma("unroll") for (int _i = 0; _i < 2; ++_i) \
        __builtin_amdgcn_global_load_lds((const unsigned*)((const char*)(gbase) + (voff)[_i]), (PG8_LAS unsigned*)(lds + (bufoff) + ldsw + _i * 8192), 16, 0, 0); } while (0)
#define PG8_LD1(dst, base) do { if constexpr (FP8) { const i32x4v lo_ = *(const PG8_LAS i32x4v*)(base), hi_ = *(const PG8_LAS i32x4v*)((base) + 1024); dst[0] = __builtin_shufflevector(lo_, hi_, 0, 1, 2, 3, 4, 5, 6, 7); } \
        else { dst[0] = *(const PG8_LAS typename FragSel<FP8>::TA*)(base); dst[FragSel<FP8>::NK - 1] = *(const PG8_LAS typename FragSel<FP8>::TA*)((base) + 1024); } } while (0)
#define PG8_LDA(dst, b, h) do { _Pragma("unroll") for (int m = 0; m < 4; ++m) PG8_LD1(dst[m], lds + PG8_SA(b, h) + aoff + m * 2048); } while (0)
#define PG8_LDB(dst, b, h) do { _Pragma("unroll") for (int n = 0; n < 2; ++n) PG8_LD1(dst[n], lds + PG8_SB(b, h) + boff + n * 2048); } while (0)
#define PG8_MMA(ai, bj, At, Bt) do { __builtin_amdgcn_s_setprio(1); if constexpr (FP8) { _Pragma("unroll") for (int m = 0; m < 4; ++m) _Pragma("unroll") for (int n = 0; n < 2; ++n) \
        acc[ai][bj][m][n] = FragSel<FP8>::mma8(Bt[n][0], At[m][0], acc[ai][bj][m][n]); } \
      else { _Pragma("unroll") for (int m = 0; m < 4; ++m) _Pragma("unroll") for (int n = 0; n < 2; ++n) _Pragma("unroll") for (int k = 0; k < 2; ++k) \
        acc[ai][bj][m][n] = FragSel<FP8>::mma16(Bt[n][k % FragSel<FP8>::NK], At[m][k % FragSel<FP8>::NK], acc[ai][bj][m][n]); } __builtin_amdgcn_s_setprio(0); } while (0)
#define PG8_WAIT_V(n) asm volatile("s_waitcnt vmcnt(" #n ")" ::: "memory")
#define PG8_WAIT_L(n) asm volatile("s_waitcnt lgkmcnt(" #n ")" ::: "memory")
#define PG8_BAR __builtin_amdgcn_s_barrier()
#define PG8_SCHED __builtin_amdgcn_sched_barrier(0)
    Unit cur, nxt; int ui = 0;
    if (!S.next(0, cur)) return;
    f32x4 acc[2][2][4][2];
#pragma unroll
    for (int a = 0; a < 2; ++a)
#pragma unroll
        for (int b = 0; b < 2; ++b)
#pragma unroll
            for (int m = 0; m < 4; ++m)
#pragma unroll
                for (int n = 0; n < 2; ++n) acc[a][b][m][n] = (f32x4){0.f, 0.f, 0.f, 0.f};
    typedef int i32x4v __attribute__((ext_vector_type(4)));
    typename FragSel<FP8>::TA At[FragSel<FP8>::NA][FragSel<FP8>::NK]; typename FragSel<FP8>::TA B0[2][FragSel<FP8>::NK], B1[2][FragSel<FP8>::NK];
    const char* cA = (const char*)g.A + (GATHER ? (size_t)0 : (size_t)cur.pm * tstep); const char* cB = (const char*)g.Bt + (size_t)cur.pn * tstep;
    if constexpr (SPLITK) { const size_t ko = (size_t)cur.pv * (size_t)g.M * kstep; cA += ko; cB += ko; }
    if constexpr (GATHER) {
#pragma unroll
        for (int h = 0; h < 2; ++h)
#pragma unroll
            for (int i = 0; i < 2; ++i) { int R, C; stage_rc(tid * 16 + i * 8192, R, C); const int v = g.gi[2 * (cur.pv * BM + h * HALF + R)]; goC[h][i] = (unsigned)(v < 0 ? 0 : v >> 1) * (unsigned)(2 * K) + (unsigned)(2 * C); }
    }
    S.a_ready(cur);
    if constexpr (SP2) {
        PG8_STAGE(PG8_SB(0, 0), cB, voffB); PG8_STAGE(PG8_SB(0, 1), cB + hstep, voffB); PG8_STAGE_A(PG8_SA(0, 0), cA, 0, goC); PG8_STAGE_A(PG8_SA(0, 1), cA, 1, goC);
        if (wr == 1) PG8_BAR;
        PG8_WAIT_V(2); PG8_BAR;
        PG8_STAGE(PG8_SB(1, 0), cB + kstep, voffB); PG8_STAGE_A(PG8_SA(1, 0), cA + kstep, 0, goC); PG8_STAGE(PG8_SB(1, 1), cB + hstep + kstep, voffB);
        PG8_WAIT_V(6); PG8_BAR;
    } else {
        PG8_STAGE(PG8_SB(0, 0), cB, voffB); PG8_STAGE_A(PG8_SA(0, 0), cA, 0, goC); PG8_STAGE(PG8_SB(0, 1), cB + hstep, voffB); PG8_STAGE_A(PG8_SA(0, 1), cA, 1, goC);
        if (wr == 1) PG8_BAR;
        PG8_WAIT_V(4); PG8_BAR;
        PG8_STAGE(PG8_SB(1, 0), cB + kstep, voffB); PG8_STAGE_A(PG8_SA(1, 0), cA + kstep, 0, goC); PG8_STAGE(PG8_SB(1, 1), cB + hstep + kstep, voffB);
        PG8_WAIT_V(6); PG8_BAR;
    }
    for (;;) {
        const bool has_next = S.next(ui + 1, nxt);
        const char* nA = (has_next && !GATHER) ? (const char*)g.A + (size_t)nxt.pm * tstep + (SPLITK ? (size_t)nxt.pv * (size_t)g.M * kstep : (size_t)0) : cA; const char* nB = has_next ? (const char*)g.Bt + (size_t)nxt.pn * tstep + (SPLITK ? (size_t)nxt.pv * (size_t)g.M * kstep : (size_t)0) : cB;
        if constexpr (GATHER) { if (has_next && wid < 2) __builtin_amdgcn_global_load_lds((const unsigned*)(g.gi + 2 * (nxt.pv * BM + wid * HALF) + 4 * lane), (PG8_LAS unsigned*)(lds + PG8_GI_OFF + wid * 1024), 16, 0, 0); }
        for (int t = 0; t < nt; t += 2) {
            const bool last = (t == nt - 2);
            const char* a1 = cA + (size_t)(t + 1) * kstep;
            const char* a2 = last ? nA : cA + (size_t)(t + 2) * kstep; const char* b2 = last ? nB : cB + (size_t)(t + 2) * kstep;
            const char* a3 = a2 + kstep; const char* b3 = b2 + kstep;
            if (last && has_next) S.a_ready(nxt);
            unsigned gs[2][2]; (void)gs;
            if constexpr (GATHER) {
                if (last && has_next) { const PG8_LAS int* gl = (const PG8_LAS int*)(lds + PG8_GI_OFF);
#pragma unroll
                    for (int h = 0; h < 2; ++h)
#pragma unroll
                        for (int i = 0; i < 2; ++i) { int R, C; stage_rc(tid * 16 + i * 8192, R, C); const int v = gl[2 * (h * HALF + R)]; goN[h][i] = (unsigned)(v < 0 ? 0 : v >> 1) * (unsigned)(2 * K) + (unsigned)(2 * C); } }
#pragma unroll
                for (int h = 0; h < 2; ++h)
#pragma unroll
                    for (int i = 0; i < 2; ++i) gs[h][i] = (last && has_next) ? goN[h][i] : goC[h][i];
            }
            if constexpr (Epi::HASFIX) { if (last) E.prefetch(cur, wid, lane); }
            if constexpr (SP2) {
            PG8_LDB(B0, 0, 0); PG8_LDB(B1, 0, 1); PG8_SCHED; PG8_LDA(At, 0, 0); PG8_STAGE_A(PG8_SA(1, 1), a1, 1, goC);
            PG8_WAIT_V(8); PG8_WAIT_L(0); PG8_BAR; PG8_MMA(0, 0, At, B0); PG8_MMA(0, 1, At, B1); PG8_BAR; PG8_SCHED;
            PG8_LDA(At, 0, 1); PG8_STAGE(PG8_SB(0, 0), b2, voffB); PG8_STAGE(PG8_SB(0, 1), b2 + hstep, voffB); PG8_STAGE_A(PG8_SA(0, 0), a2, 0, gs);
            PG8_WAIT_V(8); PG8_WAIT_L(0); PG8_BAR; PG8_MMA(1, 0, At, B0); PG8_MMA(1, 1, At, B1); PG8_BAR; PG8_SCHED;
            PG8_LDB(B0, 1, 0); PG8_LDB(B1, 1, 1); PG8_SCHED; PG8_LDA(At, 1, 0); PG8_STAGE_A(PG8_SA(0, 1), a2, 1, gs);
            PG8_WAIT_V(8); PG8_WAIT_L(0); PG8_BAR; PG8_MMA(0, 0, At, B0); PG8_MMA(0, 1, At, B1); PG8_BAR; PG8_SCHED;
            PG8_LDA(At, 1, 1); PG8_STAGE(PG8_SB(1, 0), b3, voffB); PG8_STAGE(PG8_SB(1, 1), b3 + hstep, voffB); PG8_STAGE_A(PG8_SA(1, 0), a3, 0, gs);
            PG8_WAIT_V(8); PG8_WAIT_L(0); PG8_BAR; PG8_MMA(1, 0, At, B0); PG8_MMA(1, 1, At, B1); PG8_BAR; PG8_SCHED;
            } else {
            PG8_LDB(B0, 0, 0); PG8_SCHED; PG8_LDA(At, 0, 0); PG8_STAGE_A(PG8_SA(1, 1), a1, 1, goC);
            PG8_WAIT_L(8); PG8_BAR; PG8_WAIT_L(0); PG8_MMA(0, 0, At, B0); PG8_BAR; PG8_SCHED;
            PG8_LDB(B1, 0, 1); PG8_STAGE(PG8_SB(0, 0), b2, voffB);
            PG8_BAR; PG8_WAIT_L(0); PG8_MMA(0, 1, At, B1); PG8_BAR;
            PG8_LDA(At, 0, 1); PG8_STAGE_A(PG8_SA(0, 0), a2, 0, gs);
            PG8_BAR; PG8_WAIT_L(0); PG8_MMA(1, 0, At, B0); PG8_BAR; PG8_SCHED;
            PG8_STAGE(PG8_SB(0, 1), b2 + hstep, voffB);
            PG8_WAIT_V(6); PG8_BAR; PG8_MMA(1, 1, At, B1); PG8_BAR;
            PG8_LDB(B0, 1, 0); PG8_SCHED; PG8_LDA(At, 1, 0); PG8_STAGE_A(PG8_SA(0, 1), a2, 1, gs);
            PG8_WAIT_L(8); PG8_BAR; PG8_WAIT_L(0); PG8_MMA(0, 0, At, B0); PG8_BAR; PG8_SCHED;
            PG8_LDB(B1, 1, 1); PG8_STAGE(PG8_SB(1, 0), b3, voffB);
            PG8_BAR; PG8_WAIT_L(0); PG8_MMA(0, 1, At, B1); PG8_BAR;
            PG8_LDA(At, 1, 1); PG8_STAGE_A(PG8_SA(1, 0), a3, 0, gs);
            PG8_BAR; PG8_WAIT_L(0); PG8_MMA(1, 0, At, B0); PG8_BAR; PG8_SCHED;
            PG8_STAGE(PG8_SB(1, 1), b3 + hstep, voffB);
            PG8_WAIT_V(6); PG8_BAR; PG8_MMA(1, 1, At, B1); PG8_BAR;
            }
        }
        if constexpr (FP8) asm volatile("s_nop 15\n\ts_nop 15" ::: "memory");
        if constexpr (ALIGN_EPI) { if (wr == 0) PG8_BAR; }
        asm volatile("" : "+s"(cur.pm), "+s"(cur.pn));
        if constexpr (!Epi::AFTER_DRAIN) { if constexpr (Epi::HASFIX) E.fix(acc, cur, wr, wc, fr, fq); E(acc, cur, wr, wc, fr, fq); S.done(cur); }
        if (!has_next) break;
#pragma unroll
        for (int a = 0; a < 2; ++a)
#pragma unroll
            for (int b = 0; b < 2; ++b)
#pragma unroll
                for (int m = 0; m < 4; ++m)
#pragma unroll
                    for (int n = 0; n < 2; ++n) acc[a][b][m][n] = (f32x4){0.f, 0.f, 0.f, 0.f};
        cur = nxt; cA = nA; cB = nB; ++ui;
        if constexpr (GATHER) {
#pragma unroll
            for (int h = 0; h < 2; ++h)
#pragma unroll
                for (int i = 0; i < 2; ++i) goC[h][i] = goN[h][i]; }
        if constexpr (ALIGN_EPI) { if (wr == 1) PG8_BAR; }
    }
    PG8_WAIT_V(0);
    if constexpr (!ALIGN_EPI) { if (wr == 0) PG8_BAR; }
    PG8_BAR;
    if constexpr (Epi::AFTER_DRAIN) { E.fused(acc, cur, wr, wc, fr, fq, lds, wid, lane); S.done(cur); }
#undef PG8_SA
#undef PG8_SB
#undef PG8_STAGE
#undef PG8_STAGE_A
#undef PG8_LDA
#undef PG8_LDB
#undef PG8_MMA
#undef PG8_LD1
#undef PG8_WAIT_V
#undef PG8_WAIT_L
#undef PG8_BAR
#undef PG8_SCHED
}
}
#include <hip/hip_bf16.h>
#include <cmath>
namespace attn3 {
using bf16=__hip_bfloat16;
using bf16x8=__attribute__((ext_vector_type(8)))short;
using s16x4=__attribute__((ext_vector_type(4)))short;
using f32x16=__attribute__((ext_vector_type(16)))float;
using u32x4=__attribute__((ext_vector_type(4)))unsigned;
constexpr int D=64,QKP=512,VP=512,OP=1024;
constexpr int NW=8,QBLK=32,QB=QBLK*NW,KVBLK=64;
constexpr int ATTN_UNIT_ROWS=QB;
__device__ __forceinline__ int crow(int r,int hi){return (r&3)+8*(r>>2)+4*hi;}
#define SBAR() __builtin_amdgcn_sched_barrier(0)
__device__ __forceinline__ void cmask(f32x16&p0,f32x16&p1,int jb,int qrel,int hi){
  const float NEG=-INFINITY; int kb=64*jb+4*hi;
  #pragma unroll
  for(int r=0;r<16;++r){int kv=kb+(r&3)+8*(r>>2); if(kv>qrel)p0[r]=NEG; if(kv+32>qrel)p1[r]=NEG;}
}

constexpr int NSLOT=3, SLOTB=8192, SLOTV=16384;
constexpr int LDS_K=0, LDS_V=NSLOT*SLOTB, LDS_WS=LDS_V+NSLOT*SLOTV, LDS_OST=LDS_WS+NW*64*4, LDS_BYTES=LDS_OST+NW*4096;
constexpr float C2=0.125f*1.4426950408889634f;
__device__ __forceinline__ void glds16(const void*gsrc,unsigned lds_dst){unsigned keep;
  asm volatile("s_mov_b32 %0, m0\n\ts_mov_b32 m0, %2\n\ts_nop 0\n\tglobal_load_lds_dwordx4 %1, off\n\ts_mov_b32 m0, %0":"=&s"(keep):"v"(gsrc),"s"(lds_dst):"memory");}
__device__ __forceinline__ float max3f(float a,float b,float c){float r;asm("v_max3_f32 %0, %1, %2, %3":"=v"(r):"v"(a),"v"(b),"v"(c));return r;}
__device__ __forceinline__ float max2f(float a,float b){float r;asm("v_max_f32_e32 %0, %1, %2":"=v"(r):"v"(a),"v"(b));return r;}
__device__ __forceinline__ float fadd_s(float a,float b){float r;asm("v_add_f32_e32 %0, %1, %2":"=v"(r):"v"(a),"v"(b));return r;}
__device__ __forceinline__ float fsub_s(float a,float b){float r;asm("v_sub_f32_e32 %0, %1, %2":"=v"(r):"v"(a),"v"(b));return r;}
typedef float f32x2_t __attribute__((ext_vector_type(2))); typedef __bf16 bf16x2_t __attribute__((ext_vector_type(2)));
__device__ __forceinline__ unsigned cvtpk_s(float lo,float hi){f32x2_t v={lo,hi};bf16x2_t b=__builtin_convertvector(v,bf16x2_t);return __builtin_bit_cast(unsigned,b);}
#define WAIT_BAR(N) asm volatile("s_waitcnt vmcnt(" #N ") lgkmcnt(0)\n\ts_barrier":::"memory")

__device__ __forceinline__ void qkt(f32x16&p0,f32x16&p1,const char*Kslot,const bf16x8*qr,int r32,int hi){ const f32x16 negm=f32x16{};
  const char*kb=Kslot+hi*1024+r32*16;
  #pragma unroll
  for(int d0=0;d0<4;++d0){
    const bf16x8 b0=*reinterpret_cast<const bf16x8*>(kb+d0*2048);
    const bf16x8 b1=*reinterpret_cast<const bf16x8*>(kb+d0*2048+512);
    if(d0==0){p0=__builtin_amdgcn_mfma_f32_32x32x16_bf16(b0,qr[0],negm,0,0,0);p1=__builtin_amdgcn_mfma_f32_32x32x16_bf16(b1,qr[0],negm,0,0,0);}
    else{p0=__builtin_amdgcn_mfma_f32_32x32x16_bf16(b0,qr[d0],p0,0,0,0);p1=__builtin_amdgcn_mfma_f32_32x32x16_bf16(b1,qr[d0],p1,0,0,0);}}
}
typedef __attribute__((address_space(3))) const char* lds_cptr;
typedef short v4i16_t __attribute__((ext_vector_type(4)));
__device__ __forceinline__ void kload8(bf16x8*kf,lds_cptr kp){
  kf[0]=*(const __attribute__((address_space(3))) bf16x8*)(kp);      kf[1]=*(const __attribute__((address_space(3))) bf16x8*)(kp+512);
  kf[2]=*(const __attribute__((address_space(3))) bf16x8*)(kp+2048); kf[3]=*(const __attribute__((address_space(3))) bf16x8*)(kp+2560);
  kf[4]=*(const __attribute__((address_space(3))) bf16x8*)(kp+4096); kf[5]=*(const __attribute__((address_space(3))) bf16x8*)(kp+4608);
  kf[6]=*(const __attribute__((address_space(3))) bf16x8*)(kp+6144); kf[7]=*(const __attribute__((address_space(3))) bf16x8*)(kp+6656);
}
__device__ __forceinline__ void kload2(bf16x8*kf,lds_cptr kp,int j){ kf[2*j]=*(const __attribute__((address_space(3))) bf16x8*)(kp+j*2048); kf[2*j+1]=*(const __attribute__((address_space(3))) bf16x8*)(kp+j*2048+512); }
__device__ __forceinline__ s16x4 vtr(lds_cptr p){ return __builtin_bit_cast(s16x4,__builtin_amdgcn_ds_read_tr16_b64_v4i16((__attribute__((address_space(3))) v4i16_t*)p)); }
__device__ __forceinline__ float rowmax(const f32x16&p0,const f32x16&p1){
  float a=max3f(p0[0],p0[1],p1[0]),b=max3f(p0[2],p0[3],p1[1]);a=max3f(a,p1[2],p1[3]);
  #pragma unroll
  for(int r=4;r<16;r+=4){a=max3f(a,p0[r],p0[r+1]);b=max3f(b,p0[r+2],p0[r+3]);a=max3f(a,p1[r],p1[r+1]);b=max3f(b,p1[r+2],p1[r+3]);}
  const float m=max2f(a,b);
  auto rr=__builtin_amdgcn_permlane32_swap(__float_as_uint(m),__float_as_uint(m),false,false);
  return max2f(__uint_as_float(rr[0]),__uint_as_float(rr[1]));
}
__device__ __forceinline__ void pv(f32x16*o,int vb,bf16x8 pa0,bf16x8 pa1,bf16x8 pa2,bf16x8 pa3){
  #pragma unroll
  for(int d0=0;d0<4;++d0){s16x4 lo[4],hi[4];
    #pragma unroll
    for(int ks=0;ks<4;++ks){
      asm volatile("ds_read_b64_tr_b16 %0,%1 offset:%c2":"=&v"(lo[ks]):"v"(vb),"i"(d0*4096+ks*1024):"memory");
      asm volatile("ds_read_b64_tr_b16 %0,%1 offset:%c2":"=&v"(hi[ks]):"v"(vb),"i"(d0*4096+ks*1024+512):"memory");}
    asm volatile("s_waitcnt lgkmcnt(0)":::"memory");SBAR();
    #define PK(k) (bf16x8){lo[k][0],lo[k][1],lo[k][2],lo[k][3],hi[k][0],hi[k][1],hi[k][2],hi[k][3]}
    o[d0]=__builtin_amdgcn_mfma_f32_32x32x16_bf16(pa0,PK(0),o[d0],0,0,0);
    o[d0]=__builtin_amdgcn_mfma_f32_32x32x16_bf16(pa1,PK(1),o[d0],0,0,0);
    o[d0]=__builtin_amdgcn_mfma_f32_32x32x16_bf16(pa2,PK(2),o[d0],0,0,0);
    o[d0]=__builtin_amdgcn_mfma_f32_32x32x16_bf16(pa3,PK(3),o[d0],0,0,0);
    #undef PK
  }
}

#ifndef ATTN_STORE16
#define ATTN_STORE16(p,v) (*(u32x4*)(p)=(v))
#endif
template<int THRL> __device__ __forceinline__ void attn_unit(long rowbase,int qb,int lseq,const bf16*Q,const bf16*__restrict__ K,const bf16*__restrict__ V,bf16*O,char*shm){
  const int tid=fresh_tid(),lane=tid&63,r32=lane&31,hi=lane>>5; const int wid=__builtin_amdgcn_readfirstlane(tid>>6);
  const int q0=qb*QB;
  const bf16*Qw=Q+(rowbase+q0+wid*QBLK)*QKP;
  const bf16*Kh=K+rowbase*QKP,*Vh=V+rowbase*VP;
  const unsigned lds0=(unsigned)(uintptr_t)shm;
  float*wsf=(float*)(shm+LDS_WS)+wid*64;
  const bf16*ksrc=Kh+(long)lane*QKP+wid*8;
  const bf16*vsrc=Vh+(long)(16*(wid&3)+(lane>>2))*VP+(wid>>2)*32+(lane&3)*8;
  const unsigned kdst=lds0+LDS_K+wid*1024, vdst=lds0+LDS_V+wid*1024;
  #define DMA_K(t,slot) glds16(ksrc+(long)(t)*KVBLK*QKP,(unsigned)__builtin_amdgcn_readfirstlane(kdst+(slot)))
  #define DMA_V(t,slot) do{ glds16(vsrc+(long)(t)*KVBLK*VP,(unsigned)__builtin_amdgcn_readfirstlane(vdst+2*(slot))); glds16(vsrc+(long)(t)*KVBLK*VP+64,(unsigned)__builtin_amdgcn_readfirstlane(vdst+2*(slot)+8192)); }while(0)
  const int vb0=(int)(lds0+LDS_V)+((lane>>4)&1)*32+(lane&3)*8+(4*hi+((lane&15)>>2))*64;
  const char*Kbase=shm+LDS_K; bf16x8 kf[8];
  const lds_cptr shm3=(lds_cptr)shm; const lds_cptr kp0=shm3+LDS_K+hi*1024+r32*16; const lds_cptr vp0=shm3+LDS_V+((lane>>4)&1)*32+(lane&3)*8+(4*hi+((lane&15)>>2))*64;
  const int NT=(q0+QB)/KVBLK;
  DMA_K(0,0);DMA_V(0,0);DMA_K(1,SLOTB);
  bf16x8 qr[4];
  #pragma unroll
  for(int d0=0;d0<4;++d0)qr[d0]=*reinterpret_cast<const bf16x8*>(&Qw[(long)r32*QKP+d0*16+hi*8]);
  float mhat=0.f,l_reg=0.f;f32x16 o[4];o[0]=f32x16{};o[1]=f32x16{};o[2]=f32x16{};o[3]=f32x16{};
  const int qrel=wid*QBLK+r32;
  #define CMASK(P0,P1,t) do{int jb_=(t)-(NT-4); if(jb_>=0)cmask(P0,P1,jb_,qrel,hi);}while(0)
  bool resc=false;
  #define START(P0,P1) do{ const float rm=rowmax(P0,P1); resc=false; \
    { const float dl=rm; mhat=fadd_s(mhat,dl); \
      _Pragma("unroll") for(int r=0;r<16;++r){P0[r]=fsub_s(P0[r],dl);P1[r]=fsub_s(P1[r],dl);} } \
    _Pragma("unroll") for(int r=0;r<16;++r)P0[r]=__builtin_amdgcn_exp2f(P0[r]); }while(0)
  #define RESC() do{ if(resc){ asm volatile("s_waitcnt lgkmcnt(0)":::"memory"); \
      _Pragma("unroll") for(int d_=0;d_<4;++d_) _Pragma("unroll") for(int r=0;r<16;++r)o[d_][r]*=wsf[crow(r,hi)]; } }while(0)
  f32x16 pA0,pA1,pB0,pB1;
  int sl_prev=0,sl_cur=0,sl_next=SLOTB;
  #define ROT() do{sl_prev=sl_cur;sl_cur=sl_next;sl_next=(sl_next==(NSLOT-1)*SLOTB)?0:sl_next+SLOTB;}while(0)
  DMA_K(2,2*SLOTB);
  WAIT_BAR(3);
  qkt(pA0,pA1,Kbase,qr,r32,hi);asm volatile("s_nop 15\n\ts_nop 7":"+v"(pA0),"+v"(pA1));CMASK(pA0,pA1,0);
  START(pA0,pA1);
  _Pragma("unroll") for(int r=0;r<16;++r)pA1[r]=__builtin_amdgcn_exp2f(pA1[r]);
  WAIT_BAR(0);
  DMA_K(3,0);DMA_V(1,SLOTB);
  ROT();
  kload8(kf,kp0+sl_cur);
  WAIT_BAR(3);
  s16x4 vlo[4],vhi[4]; u32x4 pw0,pw1,pw2,pw3;
  #define PKW(P,B) cvtpk_s(P[B],P[B+1])
  #define PAF(k) __builtin_bit_cast(bf16x8,pw##k)
  #define VSL(i) (bf16x8){vlo[i][0],vlo[i][1],vlo[i][2],vlo[i][3],vhi[i][0],vhi[i][1],vhi[i][2],vhi[i][3]}
  #define PIN(x) asm volatile("":"+v"(x))
  #define MX3(a,b,c) __builtin_fmaxf(__builtin_fmaxf((a),(b)),(c))
  #define GAPA(MF,A0,A1,A2,A3,W0,W1,PW) do{ MF; sacc+=A0; sacc+=A1; sacc+=A2; sacc+=A3; PIN(sacc); W0; W1; PIN(PW); SBAR(); }while(0)
  #define EX(v) __builtin_amdgcn_exp2f(v)
  #define GAPB(MF,RD,X,B) do{ MF; RD; X[B]=EX(X[B]-mhat); X[B+1]=EX(X[B+1]-mhat); PIN(X); SBAR(); }while(0)
  #define VRDF(s,f) do{ vlo[s]=vtr(vp_+(((f)>>2)*4096+((f)&3)*1024)); vhi[s]=vtr(vp_+(((f)>>2)*4096+((f)&3)*1024+512)); }while(0)
  #define KRD(G,j) do{ if(G){ kload2(kf,kp0+sl_next,j); SBAR(); } }while(0)
  #define STEP(C0,C1,P0,P1,t,GK,GV,GL) do{ SBAR(); \
    const lds_cptr vp_=vp0+2*sl_prev; \
    float sacc=(P0[0]+P0[1]); \
    GAPA(C0=__builtin_amdgcn_mfma_f32_32x32x16_bf16(kf[0],qr[0],f32x16{},0,0,0), P0[2],P0[3],P0[4],P0[5],     pw0[0]=PKW(P0,0), pw0[1]=PKW(P0,2), pw0); \
    GAPA(C1=__builtin_amdgcn_mfma_f32_32x32x16_bf16(kf[1],qr[0],f32x16{},0,0,0), P0[6],P0[7],P0[8],P0[9],     pw0[2]=PKW(P0,4), pw0[3]=PKW(P0,6), pw0); \
    GAPA(C0=__builtin_amdgcn_mfma_f32_32x32x16_bf16(kf[2],qr[1],C0,0,0,0),   P0[10],P0[11],P0[12],P0[13], pw1[0]=PKW(P0,8), pw1[1]=PKW(P0,10), pw1); \
    GAPA(C1=__builtin_amdgcn_mfma_f32_32x32x16_bf16(kf[3],qr[1],C1,0,0,0),   P0[14],P0[15],P1[0],P1[1],   pw1[2]=PKW(P0,12),pw1[3]=PKW(P0,14), pw1); \
    VRDF(0,0); SBAR(); GAPA(C0=__builtin_amdgcn_mfma_f32_32x32x16_bf16(kf[4],qr[2],C0,0,0,0),   P1[2],P1[3],P1[4],P1[5],     pw2[0]=PKW(P1,0), pw2[1]=PKW(P1,2), pw2); \
    VRDF(1,4); SBAR(); GAPA(C1=__builtin_amdgcn_mfma_f32_32x32x16_bf16(kf[5],qr[2],C1,0,0,0),   P1[6],P1[7],P1[8],P1[9],     pw2[2]=PKW(P1,4), pw2[3]=PKW(P1,6), pw2); \
    VRDF(2,1); SBAR(); GAPA(C0=__builtin_amdgcn_mfma_f32_32x32x16_bf16(kf[6],qr[3],C0,0,0,0),   P1[10],P1[11],P1[12],P1[13], pw3[0]=PKW(P1,8), pw3[1]=PKW(P1,10), pw3); \
    VRDF(3,5); SBAR(); GAPA(C1=__builtin_amdgcn_mfma_f32_32x32x16_bf16(kf[7],qr[3],C1,0,0,0),   P1[14],P1[15],0.f,0.f,       pw3[2]=PKW(P1,12),pw3[3]=PKW(P1,14), pw3); \
    l_reg+=sacc; \
    if(GK){DMA_K((t)+3,sl_cur);} if(GV){DMA_V((t)+1,sl_next);} \
    CMASK(C0,C1,t); \
    { float a=MX3(C0[0],C0[1],C1[0]),b=MX3(C0[2],C0[3],C1[1]); a=MX3(a,C1[2],C1[3]); \
      _Pragma("unroll") for(int r=4;r<16;r+=4){a=MX3(a,C0[r],C0[r+1]);b=MX3(b,C0[r+2],C0[r+3]);a=MX3(a,C1[r],C1[r+1]);b=MX3(b,C1[r+2],C1[r+3]);} \
      float rm=__builtin_fmaxf(a,b); { auto rr=__builtin_amdgcn_permlane32_swap(__float_as_uint(rm),__float_as_uint(rm),false,false); rm=__builtin_fmaxf(__uint_as_float(rr[0]),__uint_as_float(rr[1])); } \
      resc=false; \
      rm-=mhat; \
      if(__builtin_expect(__any(rm>(float)THRL),0)){ const float dl=__builtin_fmaxf(rm,0.f); mhat+=dl; \
        const float f=__builtin_amdgcn_exp2f(-dl); l_reg*=f; if(hi==0)wsf[r32]=f; resc=true; } } \
    SBAR(); \
    GAPB(o[0]=__builtin_amdgcn_mfma_f32_32x32x16_bf16(PAF(0),VSL(0),o[0],0,0,0), VRDF(0,2), C0,0); \
    GAPB(o[1]=__builtin_amdgcn_mfma_f32_32x32x16_bf16(PAF(0),VSL(1),o[1],0,0,0), VRDF(1,6), C0,2); \
    KRD(GL,0); GAPB(o[0]=__builtin_amdgcn_mfma_f32_32x32x16_bf16(PAF(1),VSL(2),o[0],0,0,0), VRDF(2,3), C0,4); \
    KRD(GL,1); GAPB(o[1]=__builtin_amdgcn_mfma_f32_32x32x16_bf16(PAF(1),VSL(3),o[1],0,0,0), VRDF(3,7), C0,6); \
    KRD(GL,2); GAPB(o[0]=__builtin_amdgcn_mfma_f32_32x32x16_bf16(PAF(2),VSL(0),o[0],0,0,0), VRDF(0,8), C0,8); \
    KRD(GL,3); GAPB(o[1]=__builtin_amdgcn_mfma_f32_32x32x16_bf16(PAF(2),VSL(1),o[1],0,0,0), VRDF(1,12), C0,10); \
    GAPB(o[0]=__builtin_amdgcn_mfma_f32_32x32x16_bf16(PAF(3),VSL(2),o[0],0,0,0), VRDF(2,9), C0,12); \
    GAPB(o[1]=__builtin_amdgcn_mfma_f32_32x32x16_bf16(PAF(3),VSL(3),o[1],0,0,0), VRDF(3,13), C0,14); \
    GAPB(o[2]=__builtin_amdgcn_mfma_f32_32x32x16_bf16(PAF(0),VSL(0),o[2],0,0,0), VRDF(0,10), C1,0); \
    GAPB(o[3]=__builtin_amdgcn_mfma_f32_32x32x16_bf16(PAF(0),VSL(1),o[3],0,0,0), VRDF(1,14), C1,2); \
    GAPB(o[2]=__builtin_amdgcn_mfma_f32_32x32x16_bf16(PAF(1),VSL(2),o[2],0,0,0), VRDF(2,11), C1,4); \
    GAPB(o[3]=__builtin_amdgcn_mfma_f32_32x32x16_bf16(PAF(1),VSL(3),o[3],0,0,0), VRDF(3,15), C1,6); \
    GAPB(o[2]=__builtin_amdgcn_mfma_f32_32x32x16_bf16(PAF(2),VSL(0),o[2],0,0,0), (void)0, C1,8); \
    GAPB(o[3]=__builtin_amdgcn_mfma_f32_32x32x16_bf16(PAF(2),VSL(1),o[3],0,0,0), (void)0, C1,10); \
    GAPB(o[2]=__builtin_amdgcn_mfma_f32_32x32x16_bf16(PAF(3),VSL(2),o[2],0,0,0), (void)0, C1,12); \
    GAPB(o[3]=__builtin_amdgcn_mfma_f32_32x32x16_bf16(PAF(3),VSL(3),o[3],0,0,0), (void)0, C1,14); \
    }while(0)
  int t=1;
  #undef CMASK
  #define CMASK(P0,P1,t) do{}while(0)
  for(;t+5<NT;t+=2){
    STEP(pB0,pB1,pA0,pA1,t,true,true,true);     WAIT_BAR(3); RESC(); ROT();
    STEP(pA0,pA1,pB0,pB1,t+1,true,true,true);   WAIT_BAR(3); RESC(); ROT();
  }
  #undef CMASK
  #define CMASK(P0,P1,t) do{int jb_=(t)-(NT-4); if(jb_>=0)cmask(P0,P1,jb_,qrel,hi);}while(0)
  #define ENDW(tt) do{ if((tt)+3<NT){WAIT_BAR(3);} else if((tt)+2<NT){WAIT_BAR(2);} else {WAIT_BAR(0);} }while(0)
  for(;t+1<NT;t+=2){
    STEP(pB0,pB1,pA0,pA1,t,(t+3<NT),(t+1<NT),(t+1<NT));       ENDW(t);   RESC(); ROT();
    STEP(pA0,pA1,pB0,pB1,t+1,(t+4<NT),(t+2<NT),(t+2<NT));     ENDW(t+1); RESC(); ROT();
  }
  STEP(pB0,pB1,pA0,pA1,NT-1,false,false,false); RESC();
  { float sacc=pB0[0]+pB0[1]; _Pragma("unroll") for(int r=2;r<16;++r)sacc+=pB0[r]; _Pragma("unroll") for(int r=0;r<16;++r)sacc+=pB1[r]; l_reg+=sacc;
    pw0=(u32x4){PKW(pB0,0),PKW(pB0,2),PKW(pB0,4),PKW(pB0,6)};pw1=(u32x4){PKW(pB0,8),PKW(pB0,10),PKW(pB0,12),PKW(pB0,14)};pw2=(u32x4){PKW(pB1,0),PKW(pB1,2),PKW(pB1,4),PKW(pB1,6)};pw3=(u32x4){PKW(pB1,8),PKW(pB1,10),PKW(pB1,12),PKW(pB1,14)};
    SBAR(); pv(o,vb0+2*sl_cur,PAF(0),PAF(1),PAF(2),PAF(3)); }
  #undef PKW
  #undef PAF
  #undef VSL
  #undef PIN
  #undef MX3
  #undef GAPA
  #undef GAPB
  #undef EX
  #undef VRDF
  #undef KRD
  #undef STEP
  #undef ENDW
  {auto rr=__builtin_amdgcn_permlane32_swap(__float_as_uint(l_reg),__float_as_uint(l_reg),false,false);l_reg=__uint_as_float(rr[0])+__uint_as_float(rr[1]);}
  if(hi==0)wsf[32+r32]=l_reg;asm volatile("s_waitcnt lgkmcnt(0)":::"memory");
  float rli[16];
  #pragma unroll
  for(int r=0;r<16;++r)rli[r]=__builtin_amdgcn_rcpf(wsf[32+crow(r,hi)]);
  bf16*Ow=O+(rowbase+q0+wid*QBLK)*OP;
  { bf16*stg=(bf16*)(shm+LDS_OST)+wid*2048;
    #pragma unroll
    for(int hf=0;hf<2;++hf){
      #pragma unroll
      for(int r=0;r<16;++r){const int orow=crow(r,hi);
        { const unsigned pk=cvtpk_s(o[2*hf][r]*rli[r],o[2*hf+1][r]*rli[r]); unsigned short*const sg=(unsigned short*)stg;
          sg[orow*64+r32]=(unsigned short)(pk&0xffffu); sg[orow*64+32+r32]=(unsigned short)(pk>>16); } }
      asm volatile("s_waitcnt lgkmcnt(0)":::"memory");
      #pragma unroll
      for(int i=0;i<4;++i){const int row=i*8+(lane>>3),ch=lane&7; const u32x4 v=*(const u32x4*)(stg+row*64+ch*8); if(q0+wid*QBLK+row<lseq)ATTN_STORE16(Ow+(long)row*OP+hf*64+ch*8,v);}
      asm volatile("s_waitcnt lgkmcnt(0)":::"memory"); } }
  asm volatile("s_waitcnt lgkmcnt(0)\n\ts_barrier":::"memory");
  #undef DMA_K
  #undef DMA_V
  #undef CMASK
  #undef START
  #undef RESC
  #undef ROT
}

constexpr int TAIL_SCR=132096;
__device__ __forceinline__ void attn_tail_unit(long rowbase,int q0,int lseq,const bf16*Q,const bf16*__restrict__ K,const bf16*__restrict__ V,bf16*O,char*shm){
  const int tid=fresh_tid(),lane=tid&63,r32=lane&31,hi=lane>>5; const int wid=__builtin_amdgcn_readfirstlane(tid>>6);
  const bf16*Kh=K+rowbase*QKP,*Vh=V+rowbase*VP;
  const unsigned lds0=(unsigned)(uintptr_t)shm; const unsigned vslot_a=lds0+(unsigned)wid*16384u;
  float*const wsf=(float*)(shm+TAIL_SCR)+wid*32; float*const ML=(float*)(shm+TAIL_SCR+1024); float*const SC=(float*)(shm+TAIL_SCR+3072);
  const int nvalid=lseq-q0;
  bf16x8 qr[4];
  #pragma unroll
  for(int d0=0;d0<4;++d0){ qr[d0]=*reinterpret_cast<const bf16x8*>(&Q[(rowbase+q0+(r32<nvalid?r32:0))*QKP+d0*16+hi*8]); if(r32>=nvalid)qr[d0]=bf16x8{}; }
  const int NTK=q0/KVBLK+1;
  float m=-INFINITY,l=0.f; f32x16 o[4]; o[0]=f32x16{};o[1]=f32x16{};o[2]=f32x16{};o[3]=f32x16{};
  const int vb=(int)vslot_a+((lane>>4)&1)*32+(lane&3)*8+(4*hi+((lane&15)>>2))*64;
  bf16x8 kf[8],kn[8];
  { const bf16*kt=Kh+((long)wid*KVBLK+r32)*QKP+hi*8;
    #pragma unroll
    for(int d0=0;d0<4;++d0){ kf[2*d0]=*reinterpret_cast<const bf16x8*>(kt+d0*16); kf[2*d0+1]=*reinterpret_cast<const bf16x8*>(kt+32*QKP+d0*16); } }
  for(int t=wid;t<NTK;t+=NW){
    asm volatile("s_waitcnt vmcnt(0)":::"memory");
    { const bf16*vt=Vh+(long)t*KVBLK*VP+(long)(lane>>2)*VP+(lane&3)*8;
      #pragma unroll
      for(int pw=0;pw<8;++pw){ const bf16*src=vt+(long)(16*(pw&3))*VP+(pw>>2)*32;
        glds16(src,(unsigned)__builtin_amdgcn_readfirstlane(vslot_a+pw*1024)); glds16(src+64,(unsigned)__builtin_amdgcn_readfirstlane(vslot_a+pw*1024+8192)); } }
    { const int tn=(t+NW<NTK)?t+NW:t; const bf16*kt=Kh+((long)tn*KVBLK+r32)*QKP+hi*8;
      #pragma unroll
      for(int d0=0;d0<4;++d0){ kn[2*d0]=*reinterpret_cast<const bf16x8*>(kt+d0*16); kn[2*d0+1]=*reinterpret_cast<const bf16x8*>(kt+32*QKP+d0*16); } }
    asm volatile("":::"memory");
    f32x16 p0=f32x16{},p1=f32x16{};
    #pragma unroll
    for(int d0=0;d0<4;++d0){ p0=__builtin_amdgcn_mfma_f32_32x32x16_bf16(kf[2*d0],qr[d0],p0,0,0,0); p1=__builtin_amdgcn_mfma_f32_32x32x16_bf16(kf[2*d0+1],qr[d0],p1,0,0,0); }
    asm volatile("s_nop 15\n\ts_nop 7":"+v"(p0),"+v"(p1));
    if(t==NTK-1)cmask(p0,p1,0,r32,hi);
    const float rm=rowmax(p0,p1);
    const float mn=__builtin_fmaxf(m,rm); const float f=__builtin_amdgcn_exp2f(m-mn); m=mn; l*=f;
    if(hi==0)wsf[r32]=f;
    float sacc=0.f;
    #pragma unroll
    for(int r=0;r<16;++r){ p0[r]=__builtin_amdgcn_exp2f(p0[r]-mn); p1[r]=__builtin_amdgcn_exp2f(p1[r]-mn); sacc+=p0[r]+p1[r]; }
    l+=sacc;
    asm volatile("s_waitcnt lgkmcnt(0)":::"memory");
    #pragma unroll
    for(int d_=0;d_<4;++d_)
      #pragma unroll
      for(int r=0;r<16;++r)o[d_][r]*=wsf[crow(r,hi)];
    const u32x4 pw0=(u32x4){cvtpk_s(p0[0],p0[1]),cvtpk_s(p0[2],p0[3]),cvtpk_s(p0[4],p0[5]),cvtpk_s(p0[6],p0[7])},pw1=(u32x4){cvtpk_s(p0[8],p0[9]),cvtpk_s(p0[10],p0[11]),cvtpk_s(p0[12],p0[13]),cvtpk_s(p0[14],p0[15])};
    const u32x4 pw2=(u32x4){cvtpk_s(p1[0],p1[1]),cvtpk_s(p1[2],p1[3]),cvtpk_s(p1[4],p1[5]),cvtpk_s(p1[6],p1[7])},pw3=(u32x4){cvtpk_s(p1[8],p1[9]),cvtpk_s(p1[10],p1[11]),cvtpk_s(p1[12],p1[13]),cvtpk_s(p1[14],p1[15])};
    asm volatile("s_waitcnt vmcnt(8)":::"memory");
    SBAR(); pv(o,vb,__builtin_bit_cast(bf16x8,pw0),__builtin_bit_cast(bf16x8,pw1),__builtin_bit_cast(bf16x8,pw2),__builtin_bit_cast(bf16x8,pw3));
    #pragma unroll
    for(int i=0;i<8;++i)kf[i]=kn[i];
  }
  asm volatile("s_waitcnt vmcnt(0)":::"memory");
  {auto rr=__builtin_amdgcn_permlane32_swap(__float_as_uint(l),__float_as_uint(l),false,false);l=__uint_as_float(rr[0])+__uint_as_float(rr[1]);}
  if(hi==0){ML[wid*64+r32]=m;ML[wid*64+32+r32]=l;}
  { float*const OPw=(float*)(shm+wid*16384);
    #pragma unroll
    for(int d_=0;d_<4;++d_)
      #pragma unroll
      for(int r=0;r<16;++r)OPw[(d_*16+r)*64+lane]=o[d_][r]; }
  asm volatile("s_waitcnt lgkmcnt(0)\n\ts_barrier":::"memory");
  if(wid<4){
    float mw[8],lw[8]; float M=-INFINITY;
    #pragma unroll
    for(int w=0;w<8;++w){mw[w]=ML[w*64+r32];lw[w]=ML[w*64+32+r32];M=__builtin_fmaxf(M,mw[w]);}
    float L=0.f;
    #pragma unroll
    for(int w=0;w<8;++w){mw[w]=__builtin_amdgcn_exp2f(mw[w]-M);L+=lw[w]*mw[w];}
    const float rl=__builtin_amdgcn_rcpf(L);
    if(hi==0){
      #pragma unroll
      for(int w=0;w<8;++w)SC[w*32+r32]=mw[w]*rl; }
    asm volatile("s_waitcnt lgkmcnt(0)":::"memory");
    float acc[8];
    #pragma unroll
    for(int r=0;r<8;++r)acc[r]=0.f;
    #pragma unroll
    for(int w=0;w<8;++w){ const float*const OPw=(const float*)(shm+w*16384);
      #pragma unroll
      for(int r=0;r<8;++r)acc[r]+=OPw[(wid*16+r)*64+lane]*SC[w*32+crow(r,hi)]; }
    #pragma unroll
    for(int r=0;r<8;++r){ const int row=crow(r,hi); if(row<nvalid)O[(rowbase+q0+row)*OP+wid*32+r32]=__float2bfloat16(acc[r]); }
  }
  asm volatile("s_waitcnt lgkmcnt(0)\n\ts_barrier":::"memory");
}
constexpr int ATTN_LDS_BYTES=LDS_BYTES;
#undef SBAR
#undef WAIT_BAR
}

constexpr int NWAVES = 8, NTHREADS = NWAVES * 64;
constexpr int DM = 1024, NB = 8, SEQ = 4096, NMETA = 16, LSEQ = SEQ + NMETA;
constexpr int M = NB * LSEQ;
constexpr int MP = 33024;
constexpr int MMAIN = NB * SEQ;
constexpr int DIN = 3072, DCONV = 512, NHEADS = 4, FF0 = 2816, NEXP = 8, FFE = 3584;
constexpr float LN_EPS = 1e-5f, RMS_EPS = 1e-5f;
constexpr float ALPHA = 1.41421356237309515f;
constexpr int MOE_CAPT = 128, MOE_CAPR = MOE_CAPT * 256;
constexpr int MOE_MAXT = 264;
constexpr int MOE_CH = 128, MOE_NCH = 2, MOE_CH_MAX = MOE_MAXT - MOE_CH;
constexpr int NPHASES = 18;
#ifndef ATTN_THRL
#define ATTN_THRL 8
#endif
#ifndef MOE_SP2
#define MOE_SP2 true
#endif
#ifndef MOE_ALIGN
#define MOE_ALIGN true
#endif
constexpr float OS_SC = 16.f;
constexpr float WS_GU = 32.f, WS_DN = 128.f;

constexpr size_t MiB = 1u << 20;
constexpr size_t WS_CTL = 0, CTL_ZERO_BYTES = 256 * 1024;
constexpr size_t WS_ROPE_C = 1 * MiB, WS_ROPE_S = 2 * MiB;
constexpr size_t WS_TOKINFO = 3 * MiB;
constexpr size_t WS_ROWINFO = 164 * MiB;
constexpr size_t WS_STATS = 256 * 1024;
constexpr size_t STATS_BYTES = (size_t)2 * MP * 8;
constexpr size_t CV_OFF = 64 * 1024;
constexpr int CV_C1GU = 0, CV_C0GU = 2 * FF0, CV_C1IN = 4 * FF0, CV_C0IN = 4 * FF0 + DIN, CV_WORDS = 4 * FF0 + 2 * DIN;
constexpr size_t WS_WMOE_GU = 6 * MiB;
constexpr size_t WS_WMOE_D = 62 * MiB;
constexpr size_t WS_H8 = 90 * MiB;
constexpr size_t WS_WGU0_8 = 122 * MiB;
constexpr size_t WS_WD0_8 = 128 * MiB;
constexpr size_t WS_X8 = 131 * MiB;
constexpr size_t WS_H = 174 * MiB;
constexpr size_t WS_WIN = 239 * MiB;
constexpr size_t WS_WOUT = 251 * MiB;
constexpr size_t WS_WGU0 = 255 * MiB;
constexpr size_t WS_WD0 = 266 * MiB;
constexpr size_t WS_S = 272 * MiB;
constexpr size_t WS_Q = WS_S, WS_K = WS_S + 33 * MiB, WS_V = WS_S + 66 * MiB, WS_UC = WS_S + 99 * MiB, WS_UH = WS_S + 132 * MiB, WS_CAT = WS_S + 165 * MiB;
constexpr size_t WS_PRE = WS_S;
constexpr size_t WS_ACT0 = WS_S, WS_PRE2 = WS_S + 178 * MiB;
constexpr size_t WS_ASORT = 239 * MiB, WS_OUTSLOT = 371 * MiB;
constexpr size_t WS_PART = WS_ASORT;
static_assert(WS_PART + (size_t)32 * 7 * 65536 * 4 <= WS_OUTSLOT, "map");
constexpr size_t WS_END = 529 * MiB;
constexpr size_t DO_UB = 0, DO_OV = 33 * MiB, DO_ACT = 0;
static_assert(WS_X8 + (size_t)32768 * DM <= WS_ROWINFO && WS_ROWINFO + (size_t)NEXP * MOE_CAPR * 8 <= WS_H && pg8::PG8_GI_OFF == 132096, "map");
static_assert(WS_H8 + (size_t)MMAIN * DM <= WS_WGU0_8 && WS_WGU0_8 + (size_t)2 * FF0 * DM <= WS_WD0_8 && WS_WD0_8 + (size_t)DM * FF0 <= WS_X8 && WS_X8 + (size_t)32768 * DM <= WS_H, "map");
static_assert(WS_H + (size_t)MP * DM * 2 <= WS_WIN && WS_WD0 + (size_t)DM * FF0 * 2 <= WS_S, "map");
static_assert(WS_CAT + (size_t)MP * DM * 2 <= WS_END && WS_PRE2 + (size_t)MP * DM * 2 <= WS_END && WS_ACT0 + (size_t)MP * FF0 * 2 <= WS_PRE2, "map");
static_assert(WS_WMOE_D + (size_t)NEXP * DM * FFE <= WS_H8 && WS_H8 + (size_t)MMAIN * DM <= WS_H && WS_ASORT + (size_t)MOE_MAXT * 256 * DM <= WS_OUTSLOT && WS_OUTSLOT + (size_t)2 * MMAIN * DM * 2 <= WS_END, "map");
static_assert(DO_OV + (size_t)MP * DM * 2 <= (size_t)MMAIN * DM * 4 && (size_t)MOE_CH_MAX * 256 * FFE <= (size_t)MMAIN * DM * 4, "d_out scratch");
constexpr int CW_TMO = 0, CW_CODE = 1, CW_BAR = 4096, CW_QCTR = 8192, CW_CNT = 8448;
static_assert((CW_CNT + 64 * 8) * 4 <= (int)CV_OFF && CV_OFF + (size_t)CV_WORDS * 4 <= CTL_ZERO_BYTES && CTL_ZERO_BYTES + STATS_BYTES <= MiB && WS_STATS == CTL_ZERO_BYTES, "ctl");

constexpr int RING_OFF = 0, RING_BYTES = 131072;
constexpr int LDSCTL_OFF = RING_BYTES, MISC_OFF = LDSCTL_OFF + 320;
constexpr int LDS_BYTES = 147456;

#define GAS __attribute__((address_space(1)))
#define LAS __attribute__((address_space(3)))
typedef unsigned short bf16;
typedef unsigned v4u __attribute__((ext_vector_type(4)));
typedef unsigned v2u __attribute__((ext_vector_type(2)));
typedef float f32x4 __attribute__((ext_vector_type(4)));
typedef GAS unsigned gu32;
#define RLX_AGENT __ATOMIC_RELAXED, __HIP_MEMORY_SCOPE_AGENT
#define LDS_WAIT() asm volatile("s_waitcnt lgkmcnt(0)" ::: "memory")
#define VM_WAIT() asm volatile("s_waitcnt vmcnt(0)" ::: "memory")
__device__ __forceinline__ unsigned f2bf(float f) { unsigned u = __builtin_bit_cast(unsigned, f); return (u + 0x7fffu + ((u >> 16) & 1u)) >> 16; }
typedef float f32x2p __attribute__((ext_vector_type(2))); typedef __bf16 bf16x2p __attribute__((ext_vector_type(2)));
__device__ __forceinline__ unsigned pk2(float lo, float hi) { const f32x2p v = {lo, hi}; const bf16x2p b = __builtin_convertvector(v, bf16x2p); return __builtin_bit_cast(unsigned, b); }
__device__ __forceinline__ unsigned pk4_fp8(float a, float b, float c, float d) { unsigned w = 0; w = (unsigned)__builtin_amdgcn_cvt_pk_fp8_f32(a, b, (int)w, false); w = (unsigned)__builtin_amdgcn_cvt_pk_fp8_f32(c, d, (int)w, true); return w; }
__device__ __forceinline__ float bflo(unsigned w) { return __builtin_bit_cast(float, w << 16); }
__device__ __forceinline__ float bfhi(unsigned w) { return __builtin_bit_cast(float, w & 0xffff0000u); }

#define XB_TMO      128
#define XB_XCNT(j)  (256  + 64 * (j))
#define XB_XSUB(j)  (1280 + 64 * (j))
#define XB_XGEN(j)  (2304 + 64 * (j))
#define XB_TOP      3328
#define XB_TOPGEN   3392
#define XCD_BAR_WORDS 3456
#define XB_SPIN_CAP (1u << 18)

__device__ __forceinline__ unsigned xb_ld(unsigned* p)              { return __hip_atomic_load(p, __ATOMIC_RELAXED, __HIP_MEMORY_SCOPE_AGENT); }
__device__ __forceinline__ unsigned xb_add(unsigned* p, unsigned v) { return __hip_atomic_fetch_add(p, v, __ATOMIC_RELAXED, __HIP_MEMORY_SCOPE_AGENT); }
__device__ __forceinline__ unsigned xb_xcc_id() { return (unsigned)__builtin_amdgcn_s_getreg((3 << 11) | 20) & 0xFu; }
#define XB_SPIN(cond, bar) do { unsigned _sp = 0; while (cond) { __builtin_amdgcn_s_sleep(1); \
    if ((++_sp & 255u) == 0u) { if (xb_ld(&(bar)[XB_TMO])) break; if (_sp > XB_SPIN_CAP) { atomicAdd(&(bar)[XB_TMO], 1u); break; } } } } while (0)

struct XcdBarrier {
    unsigned* bar; unsigned x;
    volatile LAS unsigned* st;
};

__device__ __forceinline__ XcdBarrier xcd_barrier_post(unsigned* bar, volatile LAS unsigned* st) {
    XcdBarrier b; b.bar = bar; b.x = xb_xcc_id(); b.st = st;
    if (threadIdx.x == 0) (void)xb_add(&bar[XB_XCNT(b.x)], 1u);
    return b;
}
__device__ __forceinline__ void xcd_barrier_complete(unsigned* bar, unsigned x, unsigned& nloc, unsigned& nx) {
    const unsigned G = gridDim.x * gridDim.y * gridDim.z;
    unsigned sum, cnt, mine, sp = 0u;
    for (;;) {
        sum = 0u; cnt = 0u; mine = 0u;
#pragma unroll
        for (unsigned j = 0; j < 16; ++j) { const unsigned c = xb_ld(&bar[XB_XCNT(j)]); sum += c; cnt += (c > 0u) ? 1u : 0u; mine = (j == x) ? c : mine; }
        if (sum == G) break;
        __builtin_amdgcn_s_sleep(1);
        if ((++sp & 255u) == 0u) { if (xb_ld(&bar[XB_TMO])) break; if (sp > XB_SPIN_CAP) { atomicAdd(&bar[XB_TMO], 1u); break; } }
    }
    nloc = mine > 0u ? mine : 1u; nx = cnt > 0u ? cnt : 1u;
}

__device__ __forceinline__ void xcd_barrier(const XcdBarrier& b) {
    asm volatile("s_waitcnt vmcnt(0)" ::: "memory");
    __syncthreads();
    if (threadIdx.x == 0) {
        unsigned* bar = b.bar;
        __builtin_amdgcn_s_waitcnt(0);
        unsigned nloc = b.st[0], nx = b.st[1];
        if (nloc == 0u) { xcd_barrier_complete(bar, b.x, nloc, nx); b.st[0] = nloc; b.st[1] = nx; }
        const unsigned old = xb_add(&bar[XB_XSUB(b.x)], 1u);
        const unsigned gen = old / nloc;
        if (old + 1u == (gen + 1u) * nloc) {
            __builtin_amdgcn_fence(__ATOMIC_RELEASE, "agent");
            asm volatile("s_waitcnt vmcnt(0)" ::: "memory");
            const unsigned og = xb_add(&bar[XB_TOP], 1u);
            const unsigned tg = og / nx;
            if (og + 1u == (tg + 1u) * nx) xb_add(&bar[XB_TOPGEN], 1u);
            else XB_SPIN(xb_ld(&bar[XB_TOPGEN]) == tg, bar);
            __builtin_amdgcn_fence(__ATOMIC_ACQUIRE, "agent");
            xb_add(&bar[XB_XGEN(b.x)], 1u);
            asm volatile("s_waitcnt vmcnt(0)" ::: "memory");
        } else {
            XB_SPIN(xb_ld(&bar[XB_XGEN(b.x)]) == gen, bar);
            __builtin_amdgcn_fence(__ATOMIC_ACQUIRE, "agent");
            asm volatile("s_waitcnt vmcnt(0)" ::: "memory");
        }
    }
    __syncthreads();
}

#ifndef MK_PER_PHASE
#define MK_PER_PHASE 0
#endif
struct Args { const float* in[23]; float* out; unsigned char* ws; int ph_lo, ph_hi; };
typedef const __attribute__((address_space(4))) Args* KArgs;
__device__ __forceinline__ KArgs kargs() { KArgs p = (KArgs)__builtin_amdgcn_kernarg_segment_ptr(); asm volatile("" : "+s"(p)); return p; }
#define AIN(i) ((const float*)kargs()->in[i])
#define WSB() ((unsigned char*)kargs()->ws)
#define DOB() ((unsigned char*)kargs()->out)
#define MOE_TE(k) (((const volatile LAS int*)(lds_base + MISC_OFF))[32 + (k)])

namespace pg8 {
constexpr float C2 = 0.125f * 1.4426950408889634f;
__device__ __forceinline__ void ln_stats(const int* st, int r, float& mu, float& rs) {
    const v2u w = *(const v2u*)(st + 2 * r); const int sx = (int)w.x, qx = (int)w.y;
    mu = (float)sx * (1.0f / (65536.0f * 1024.0f)); const float ex2 = (float)qx * (1.0f / (4096.0f * 1024.0f));
    rs = __builtin_amdgcn_rsqf(ex2 - mu * mu + LN_EPS);
}
__device__ __forceinline__ f32x4 cv4(const int* c, int i) { typedef int i32x4v __attribute__((ext_vector_type(4))); const i32x4v v = *(const i32x4v*)(c + i); return (f32x4){(float)v[0], (float)v[1], (float)v[2], (float)v[3]} * (1.0f / 1048576.0f); }
constexpr int FIX_LDS_OFF = 132096;
template <int WHICH> __device__ __forceinline__ void ln_fix_prefetch(PG8_LAS unsigned char* ring, const Unit& u, int wid, int lane) {
    if (wid < 4) {
        unsigned char* const ws = WSB(); const int* const st = (const int*)(ws + WS_STATS) + (WHICH == 1 ? 0 : 2 * MP);
        const int* const cb = (const int*)(ws + WS_CTL + CV_OFF);
        const int* src = wid == 0 ? cb + (WHICH == 1 ? CV_C1GU : CV_C1IN) + u.pn * BM : wid == 1 ? cb + (WHICH == 1 ? CV_C0GU : CV_C0IN) + u.pn * BM : st + 2 * (u.pm * BM + (wid - 2) * 128);
        __builtin_amdgcn_global_load_lds((const unsigned*)(src + 4 * lane), (PG8_LAS unsigned*)(ring + FIX_LDS_OFF + wid * 1024), 16, 0, 0);
    }
}
__device__ __forceinline__ void ln_stats_lds(const PG8_LAS int* st, int rl, float& mu, float& rs) {
    typedef int i32x2v __attribute__((ext_vector_type(2))); const i32x2v w = *(const PG8_LAS i32x2v*)(st + 2 * rl); const int sx = w.x, qx = w.y;
    mu = (float)sx * (1.0f / (65536.0f * 1024.0f)); const float ex2 = (float)qx * (1.0f / (4096.0f * 1024.0f)); rs = __builtin_amdgcn_rsqf(ex2 - mu * mu + LN_EPS);
}
template <int WHICH> __device__ __forceinline__ f32x4 cv4_lds(const PG8_LAS int* c, int i) { typedef int i32x4v __attribute__((ext_vector_type(4))); const i32x4v v = *(const PG8_LAS i32x4v*)(c + i);
    return (f32x4){(float)v[0], (float)v[1], (float)v[2], (float)v[3]} * ((WHICH == 1 ? WS_GU : 1.0f) / 1048576.0f); }
template <int WHICH> __device__ __forceinline__ void ln_fix_tile(f32x4 (&acc)[2][2][4][2], PG8_LAS unsigned char* ring, int wr, int wc, int fr, int fq) {
    const PG8_LAS int* const c1 = (const PG8_LAS int*)(ring + FIX_LDS_OFF); const PG8_LAS int* const c0 = c1 + 256; const PG8_LAS int* const st = c1 + 512;
    const int row0 = wr * 64 + fr, colg = wc * 32 + 8 * fq;
    float mu[2][4], rs[2][4];
#pragma unroll
    for (int ai = 0; ai < 2; ++ai)
#pragma unroll
        for (int m = 0; m < 4; ++m) ln_stats_lds(st, row0 + ai * HALF + m * 16, mu[ai][m], rs[ai][m]);
#pragma unroll
    for (int bj = 0; bj < 2; ++bj)
#pragma unroll
        for (int n = 0; n < 2; ++n) { const f32x4 k1 = cv4_lds<WHICH>(c1, colg + bj * HALF + 4 * n), k0 = cv4_lds<WHICH>(c0, colg + bj * HALF + 4 * n);
#pragma unroll
            for (int ai = 0; ai < 2; ++ai)
#pragma unroll
                for (int m = 0; m < 4; ++m) acc[ai][bj][m][n] = (acc[ai][bj][m][n] - k1 * mu[ai][m]) * rs[ai][m] + k0; }
}
template <bool L1> struct EpiInProj {
    static constexpr bool PERM = true, AFTER_DRAIN = false, HASFIX = L1;
    PG8_LAS unsigned char* ring;
    __device__ __forceinline__ void prefetch(const Unit& u, int wid, int lane) const { ln_fix_prefetch<2>(ring, u, wid, lane); }
    __device__ __forceinline__ void fix(f32x4 (&acc)[2][2][4][2], const Unit& u, int wr, int wc, int fr, int fq) const { ln_fix_tile<2>(acc, ring, wr, wc, fr, fq); }
    __device__ __forceinline__ void operator()(const f32x4 (&acc)[2][2][4][2], const Unit& u, int wr, int wc, int fr, int fq) const {
        const int kind = u.pn >> 1, colt = (u.pn & 1) * 256, row0 = u.pm * BM + wr * 64 + fr;
        unsigned char* const ws = WSB();
        bf16_t* base = kind == 0 ? (bf16_t*)(DOB() + DO_UB) : (bf16_t*)(ws + (kind == 1 ? WS_UC : kind == 2 ? WS_UH : kind == 3 ? WS_Q : kind == 4 ? WS_K : WS_V));
        const float* const cs = (const float*)(ws + WS_ROPE_C); const float* const sn = (const float*)(ws + WS_ROPE_S);
        if (kind == 3 || kind == 4) {
            const float sc = kind == 3 ? C2 : 1.0f; const int d0 = 16 * (wc & 1) + 4 * fq;
            f32x4 cc[2][4], ss[2][4];
#pragma unroll
            for (int ai = 0; ai < 2; ++ai)
#pragma unroll
                for (int m = 0; m < 4; ++m) { const int r = row0 + ai * HALF + m * 16; const int t = r % 4112; cc[ai][m] = *(const f32x4*)(cs + t * 32 + d0); ss[ai][m] = *(const f32x4*)(sn + t * 32 + d0); }
#pragma unroll
            for (int ai = 0; ai < 2; ++ai)
#pragma unroll
                for (int m = 0; m < 4; ++m) { const int r = row0 + ai * HALF + m * 16; const f32x4 c4 = cc[ai][m], s4 = ss[ai][m];
#pragma unroll
                    for (int bj = 0; bj < 2; ++bj) { const int G = 2 * bj + (wc >> 1); const f32x4 lo = acc[ai][bj][m][0], hi = acc[ai][bj][m][1];
                        const f32x4 olo = (lo * c4 - hi * s4) * sc, ohi = (hi * c4 + lo * s4) * sc;
                        bf16_t* p = base + (size_t)r * 512 + colt + 64 * G + d0;
                        typedef unsigned u32x2 __attribute__((ext_vector_type(2)));
                        u32x2 a, b; a.x = cvt_pk_bf16(olo[0], olo[1]); a.y = cvt_pk_bf16(olo[2], olo[3]); b.x = cvt_pk_bf16(ohi[0], ohi[1]); b.y = cvt_pk_bf16(ohi[2], ohi[3]);
                        *(u32x2*)p = a; *(u32x2*)(p + 32) = b; } }
        } else {
            const int col0 = colt + wc * 32 + 8 * fq;
#pragma unroll
            for (int ai = 0; ai < 2; ++ai)
#pragma unroll
                for (int m = 0; m < 4; ++m) { bf16_t* rowp = base + (size_t)(row0 + ai * HALF + m * 16) * 512 + col0;
#pragma unroll
                    for (int bj = 0; bj < 2; ++bj) { const f32x4 v0 = acc[ai][bj][m][0], v1 = acc[ai][bj][m][1];
                        u32x4 w; w.x = cvt_pk_bf16(v0[0], v0[1]); w.y = cvt_pk_bf16(v0[2], v0[3]); w.z = cvt_pk_bf16(v1[0], v1[1]); w.w = cvt_pk_bf16(v1[2], v1[3]);
                        *(u32x4*)(rowp + bj * HALF) = w; } }
        }
    }
};
__device__ __forceinline__ float silu_mul(float g, float u) { return g * __builtin_amdgcn_rcpf(1.0f + __builtin_amdgcn_exp2f(-1.4426950408889634f * g)) * u; }
typedef float f32x2 __attribute__((ext_vector_type(2)));
template <bool SCALED> __device__ __forceinline__ f32x2 silu_mul2(f32x2 g, f32x2 u, float c1, float s2) {
    const f32x2 a = g * c1; f32x2 e; e.x = __builtin_amdgcn_exp2f(a.x); e.y = __builtin_amdgcn_exp2f(a.y);
    const f32x2 d = e + 1.0f; f32x2 r; r.x = __builtin_amdgcn_rcpf(d.x); r.y = __builtin_amdgcn_rcpf(d.y);
    f32x2 t = (g * u) * r; if (SCALED) t = t * s2; return t;
}
struct EpiSwiGLU {
    static constexpr bool PERM = true, AFTER_DRAIN = false, HASFIX = true;
    PG8_LAS unsigned char* ring;
    __device__ __forceinline__ void prefetch(const Unit& u, int wid, int lane) const { ln_fix_prefetch<1>(ring, u, wid, lane); }
    __device__ __forceinline__ void fix(f32x4 (&acc)[2][2][4][2], const Unit& u, int wr, int wc, int fr, int fq) const { ln_fix_tile<1>(acc, ring, wr, wc, fr, fq); }
    __device__ __forceinline__ void operator()(const f32x4 (&acc)[2][2][4][2], const Unit& u, int wr, int wc, int fr, int fq) const {
        unsigned char* const O = WSB() + WS_ACT0; constexpr float s = 1.0f / WS_GU;
        const int row0 = u.pm * BM + wr * 64 + fr, col0 = u.pn * 128 + wc * 32 + 8 * fq;
#pragma unroll
        for (int ai = 0; ai < 2; ++ai)
#pragma unroll
            for (int m = 0; m < 4; ++m) { unsigned char* rowp = O + (size_t)(row0 + ai * HALF + m * 16) * FF0 + col0;
                const f32x4 g0 = acc[ai][0][m][0], g1 = acc[ai][0][m][1], u0 = acc[ai][1][m][0], u1 = acc[ai][1][m][1];
                constexpr float C1 = -1.4426950408889634f * s, S2 = s * s;
                const f32x2 a0 = silu_mul2<true>((f32x2){g0[0], g0[1]}, (f32x2){u0[0], u0[1]}, C1, S2), a1 = silu_mul2<true>((f32x2){g0[2], g0[3]}, (f32x2){u0[2], u0[3]}, C1, S2);
                const f32x2 a2 = silu_mul2<true>((f32x2){g1[0], g1[1]}, (f32x2){u1[0], u1[1]}, C1, S2), a3 = silu_mul2<true>((f32x2){g1[2], g1[3]}, (f32x2){u1[2], u1[3]}, C1, S2);
                typedef unsigned u32x2 __attribute__((ext_vector_type(2)));
                u32x2 w; w.x = pk4_fp8(a0.x, a0.y, a1.x, a1.y); w.y = pk4_fp8(a2.x, a2.y, a3.x, a3.y);
                *(u32x2*)rowp = w; }
    }
};
struct EpiSwiGLU8 {
    static constexpr bool PERM = true, AFTER_DRAIN = false, HASFIX = false;
    LAS unsigned char* lds_base; int t0;
    __device__ __forceinline__ void operator()(const f32x4 (&acc)[2][2][4][2], const Unit& u, int wr, int wc, int fr, int fq) const {
        constexpr int npn = FFE / 128; constexpr float s = 1.0f / WS_GU;
        unsigned char* const O = DOB() + DO_ACT;
        const int tg = u.pm; int e = 0;
#pragma unroll
        for (int k = 0; k < 7; ++k) e += (tg >= MOE_TE(k)) ? 1 : 0;
        const int pc = u.pn - e * npn, prow = u.pm - t0;
        const int row0 = prow * BM + wr * 64 + fr, col0 = pc * 128 + wc * 32 + 8 * fq;
#pragma unroll
        for (int ai = 0; ai < 2; ++ai)
#pragma unroll
            for (int m = 0; m < 4; ++m) { unsigned char* rowp = O + (size_t)(row0 + ai * HALF + m * 16) * FFE + col0;
                const f32x4 g0 = acc[ai][0][m][0], g1 = acc[ai][0][m][1], u0 = acc[ai][1][m][0], u1 = acc[ai][1][m][1];
                constexpr float C1 = -1.4426950408889634f * s, S2 = s * s;
                const f32x2 a0 = silu_mul2<true>((f32x2){g0[0], g0[1]}, (f32x2){u0[0], u0[1]}, C1, S2), a1 = silu_mul2<true>((f32x2){g0[2], g0[3]}, (f32x2){u0[2], u0[3]}, C1, S2);
                const f32x2 a2 = silu_mul2<true>((f32x2){g1[0], g1[1]}, (f32x2){u1[0], u1[1]}, C1, S2), a3 = silu_mul2<true>((f32x2){g1[2], g1[3]}, (f32x2){u1[2], u1[3]}, C1, S2);
                typedef unsigned u32x2 __attribute__((ext_vector_type(2)));
                u32x2 w; w.x = pk4_fp8(a0.x, a0.y, a1.x, a1.y); w.y = pk4_fp8(a2.x, a2.y, a3.x, a3.y);
                *(u32x2*)rowp = w; }
    }
};
template <int MODE, bool ACC8> __device__ __forceinline__ void resid8(const u32x4 h, const f32x4 v0, const f32x4 v1, float mu, float rs, const f32x4 (&gg)[2], const f32x4 (&bb)[2], float& s, float& q, u32x4& w, v2u& w8) {
    float x[8] = {__builtin_bit_cast(float, h.x << 16), __builtin_bit_cast(float, h.x & 0xffff0000u), __builtin_bit_cast(float, h.y << 16), __builtin_bit_cast(float, h.y & 0xffff0000u),
                  __builtin_bit_cast(float, h.z << 16), __builtin_bit_cast(float, h.z & 0xffff0000u), __builtin_bit_cast(float, h.w << 16), __builtin_bit_cast(float, h.w & 0xffff0000u)};
#pragma unroll
    for (int i = 0; i < 8; ++i) { float hv = x[i]; if (MODE != 0) hv = (hv - mu) * rs * gg[i >> 2][i & 3] + bb[i >> 2][i & 3];
        x[i] = ALPHA * hv + (i < 4 ? v0[i & 3] : v1[i & 3]) * (ACC8 ? 1.0f / WS_DN : 1.0f); s += x[i]; q += x[i] * x[i]; }
    w.x = cvt_pk_bf16(x[0], x[1]); w.y = cvt_pk_bf16(x[2], x[3]); w.z = cvt_pk_bf16(x[4], x[5]); w.w = cvt_pk_bf16(x[6], x[7]);
    if (MODE == 0) { w8.x = pk4_fp8(x[0], x[1], x[2], x[3]); w8.y = pk4_fp8(x[4], x[5], x[6], x[7]); }
}
template <int MODE> struct EpiResid {
    static constexpr bool PERM = true, AFTER_DRAIN = false, HASFIX = false;
    int dummy;
    __device__ __forceinline__ void operator()(const f32x4 (&acc)[2][2][4][2], const Unit& u, int wr, int wc, int fr, int fq) const {
        const int row0 = u.pm * BM + wr * 64 + fr, col0 = u.pn * BM + wc * 32 + 8 * fq;
        unsigned char* const ws = WSB(); bf16_t* const X = (bf16_t*)(ws + WS_H); bf16_t* const P = MODE == 2 ? (bf16_t*)(ws + WS_PRE) : X;
        int* const sti = (int*)(ws + WS_STATS) + (MODE == 1 ? 0 : 2 * MP);
        int* const sto = (int*)(ws + WS_STATS) + (MODE == 0 ? 0 : 2 * MP);
        const float* const lg = kargs()->in[MODE == 1 ? 12 : 14]; const float* const lb = kargs()->in[MODE == 1 ? 13 : 15];
        f32x4 gg[2][2], bb[2][2];
        if (MODE != 0) {
#pragma unroll
            for (int bj = 0; bj < 2; ++bj)
#pragma unroll
                for (int n = 0; n < 2; ++n) { gg[bj][n] = *(const f32x4*)(lg + col0 + bj * HALF + 4 * n); bb[bj][n] = *(const f32x4*)(lb + col0 + bj * HALF + 4 * n); }
        }
#pragma unroll
        for (int ai = 0; ai < 2; ++ai) {
            u32x4 hh[4][2]; float mu[4], rs[4];
#pragma unroll
            for (int m = 0; m < 4; ++m) { const int r = row0 + ai * HALF + m * 16; const size_t off = (size_t)r * 1024 + col0;
                hh[m][0] = *(const u32x4*)(X + off); hh[m][1] = *(const u32x4*)(X + off + HALF);
                if (MODE != 0) ln_stats(sti, r, mu[m], rs[m]); else { mu[m] = 0.f; rs[m] = 1.f; } }
#pragma unroll
            for (int m = 0; m < 4; ++m) { const int r = row0 + ai * HALF + m * 16; const size_t off = (size_t)r * 1024 + col0;
                float s = 0.f, q = 0.f; u32x4 w0, w1; v2u e0, e1;
                resid8<MODE, MODE == 1>(hh[m][0], acc[ai][0][m][0], acc[ai][0][m][1], mu[m], rs[m], gg[0], bb[0], s, q, w0, e0);
                resid8<MODE, MODE == 1>(hh[m][1], acc[ai][1][m][0], acc[ai][1][m][1], mu[m], rs[m], gg[1], bb[1], s, q, w1, e1);
                *(u32x4*)(P + off) = w0; *(u32x4*)(P + off + HALF) = w1;
                if (MODE == 0) { unsigned char* const X8 = ws + WS_X8; *(v2u*)(X8 + off) = e0; *(v2u*)(X8 + off + HALF) = e1; }
                if (MODE != 2) { s += __shfl_xor(s, 16); s += __shfl_xor(s, 32); q += __shfl_xor(q, 16); q += __shfl_xor(q, 32);
                    if (fq < 2) __hip_atomic_fetch_add(sto + 2 * r + fq, fq == 0 ? __float2int_rn(s * 65536.0f) : __float2int_rn(q * 4096.0f), __ATOMIC_RELAXED, __HIP_MEMORY_SCOPE_AGENT); } }
        }
    }
};
struct EpiMoeDown {
    static constexpr bool PERM = true, AFTER_DRAIN = false, HASFIX = false;
    LAS unsigned char* lds_base; int t0;
    __device__ __forceinline__ void operator()(const f32x4 (&acc)[2][2][4][2], const Unit& u, int wr, int wc, int fr, int fq) const {
        constexpr int npn = DM / 256, mmain = MMAIN; unsigned char* const ws = WSB(); const int* const rowinfo = (const int*)(ws + WS_ROWINFO); bf16_t* const OS = (bf16_t*)(ws + WS_OUTSLOT);
        const int tg = t0 + u.pm; int e = 0;
#pragma unroll
        for (int k = 0; k < 7; ++k) e += (tg >= MOE_TE(k)) ? 1 : 0;
        int pte = 0;
#pragma unroll
        for (int k = 0; k < 7; ++k) { const int tv = MOE_TE(k); if (tg >= tv) pte = tv; }
        const int pc = u.pn - e * npn; const int row0 = (e * MOE_CAPT + (tg - pte)) * BM + wr * 64 + fr, col0 = pc * BM + wc * 32 + 8 * fq;
        int tsv[2][4]; float gtv[2][4];
#pragma unroll
        for (int ai = 0; ai < 2; ++ai)
#pragma unroll
            for (int m = 0; m < 4; ++m) { const int r = row0 + ai * HALF + m * 16; const v2u ri = *(const v2u*)(rowinfo + 2 * r); const unsigned rx = ri.x, ry = ri.y;
                tsv[ai][m] = (int)rx; gtv[ai][m] = __builtin_bit_cast(float, ry) * (OS_SC / WS_DN); }
#pragma unroll
        for (int ai = 0; ai < 2; ++ai)
#pragma unroll
            for (int m = 0; m < 4; ++m) { const int ts = tsv[ai][m]; const float gt = gtv[ai][m];
                if (ts >= 0) { unsigned char* rowp = (unsigned char*)OS + ((size_t)(ts & 1) * mmain + (size_t)(ts >> 1)) * 1024 + col0;
#pragma unroll
                    for (int bj = 0; bj < 2; ++bj) { const f32x4 v0 = acc[ai][bj][m][0] * gt, v1 = acc[ai][bj][m][1] * gt;
                        v2u w; w.x = pk4_fp8(v0[0], v0[1], v0[2], v0[3]); w.y = pk4_fp8(v1[0], v1[1], v1[2], v1[3]);
                        *(v2u*)(rowp + bj * HALF) = w; } } }
    }
};
constexpr int MOE_NSL = 7;
template <bool A_GLOBAL> struct MoeOrder {
    LAS unsigned char* lds_base; int t0, ntl, npn, G, c; int i0 = 0, iend = 1 << 30, sbase = -1;
    __device__ __forceinline__ void decode(int L, int& pml, int& pc, int& e, int& pte) const {
        const int nwg = ntl * npn; int wgid = L; { const int q = nwg / NXCD, r = nwg % NXCD, xcd = wgid % NXCD, off = wgid / NXCD; wgid = (xcd < r ? xcd * (q + 1) : r * (q + 1) + (xcd - r) * q) + off; }
        const int nig = WGM * npn, gid = wgid / nig, fm = gid * WGM, gsz = (ntl - fm) < WGM ? (ntl - fm) : WGM;
        pml = fm + ((wgid % nig) % gsz); pc = (wgid % nig) / gsz; const int tg = t0 + pml; e = 0; pte = 0;
#pragma unroll
        for (int k = 0; k < 7; ++k) { const int tv = MOE_TE(k); if (tg >= tv) { e = k + 1; pte = tv; } }
    }
    __device__ __forceinline__ bool next_lane(int i, Unit& u) const {
        const int nwg = ntl * npn; long L; int slice = 0, slot = 0;
        if (sbase >= 0) { const long j = (long)i * G + c; L = sbase + j / MOE_NSL; slice = (int)(j % MOE_NSL); slot = (int)j; }
        else { if (i + i0 >= iend) return false; L = (long)(i + i0) * G + c; }
        if (L >= nwg) return false;
        int pml, pc, e, pte; decode((int)L, pml, pc, e, pte); const int tg = t0 + pml;
        u.pm = A_GLOBAL ? tg : pml; u.pn = e * npn + pc; u.pv = sbase >= 0 ? slice : e * MOE_CAPT + (tg - pte); u.pq = slot; return true;
    }
    __device__ __forceinline__ void a_ready(const Unit&) const {}
    __device__ __forceinline__ void done(const Unit&) const {}
};
struct EpiPartial {
    static constexpr bool PERM = true, AFTER_DRAIN = false, HASFIX = false;
    float* part;
    __device__ __forceinline__ void operator()(const f32x4 (&acc)[2][2][4][2], const Unit& u, int wr, int wc, int fr, int fq) const {
        float* const base = part + (size_t)u.pq * 65536 + 4 * (((wr * 4 + wc) * 64) + fq * 16 + fr);
#pragma unroll
        for (int ai = 0; ai < 2; ++ai)
#pragma unroll
            for (int bj = 0; bj < 2; ++bj)
#pragma unroll
                for (int m = 0; m < 4; ++m)
#pragma unroll
                    for (int n = 0; n < 2; ++n) *(f32x4*)(base + ((((ai * 2 + bj) * 4 + m) * 2 + n) * 2048)) = acc[ai][bj][m][n];
    }
};
}


constexpr int TAIL_R0 = 32768, MMAIN_ROWS = 32768;
template <class TEpi> __device__ __forceinline__ void tail_gemm(const bf16* A, const bf16* Bt, const int K, const int ntn, const int vcu, const int G, const int lane, const int wave, LAS unsigned char* lds, const TEpi& E) {
    typedef short bf16x8 __attribute__((ext_vector_type(8)));
    const int fr = lane & 15, fq = lane >> 4, ntasks = 32 * ntn, kc = K >> 3;
    LAS f32x4* const P = (LAS f32x4*)lds;
    for (int task = vcu; task < ntasks; task += G) {
        const int rg = task & 7, wc = (task >> 3) & 3, pn = task >> 5, row = TAIL_R0 + 16 * rg + fr;
        const GAS bf16* ap = (const GAS bf16*)A + (size_t)row * K + wave * kc + 8 * fq;
        const GAS bf16* bp = (const GAS bf16*)Bt + (size_t)(256 * pn + 32 * wc + 8 * (fr >> 2) + (fr & 3)) * K + wave * kc + 8 * fq;
        const size_t o4 = (size_t)4 * K, o128 = (size_t)128 * K;
        const typename TEpi::Pre pre = E.pre(row, pn, wc, fq);
        f32x4 acc[2][2];
#pragma unroll
        for (int i = 0; i < 2; ++i)
#pragma unroll
            for (int j = 0; j < 2; ++j) acc[i][j] = (f32x4){0.f, 0.f, 0.f, 0.f};
#pragma unroll 4
        for (int k = 0; k < kc; k += 32) {
            const bf16x8 a = *(const GAS bf16x8*)(ap + k);
            const bf16x8 b00 = *(const GAS bf16x8*)(bp + k), b01 = *(const GAS bf16x8*)(bp + o4 + k), b10 = *(const GAS bf16x8*)(bp + o128 + k), b11 = *(const GAS bf16x8*)(bp + o128 + o4 + k);
            acc[0][0] = __builtin_amdgcn_mfma_f32_16x16x32_bf16(b00, a, acc[0][0], 0, 0, 0);
            acc[0][1] = __builtin_amdgcn_mfma_f32_16x16x32_bf16(b01, a, acc[0][1], 0, 0, 0);
            acc[1][0] = __builtin_amdgcn_mfma_f32_16x16x32_bf16(b10, a, acc[1][0], 0, 0, 0);
            acc[1][1] = __builtin_amdgcn_mfma_f32_16x16x32_bf16(b11, a, acc[1][1], 0, 0, 0);
        }
#pragma unroll
        for (int i = 0; i < 2; ++i)
#pragma unroll
            for (int j = 0; j < 2; ++j) P[(wave * 4 + i * 2 + j) * 64 + lane] = acc[i][j];
        __syncthreads();
        if (wave == 0) {
#pragma unroll
            for (int i = 0; i < 2; ++i)
#pragma unroll
                for (int j = 0; j < 2; ++j) { f32x4 s = acc[i][j];
#pragma unroll
                    for (int w = 1; w < 8; ++w) s += P[(w * 4 + i * 2 + j) * 64 + lane];
                    acc[i][j] = s; }
            E(acc, row, pn, wc, fq, pre);
        }
        __syncthreads();
    }
}
typedef int i32x4t __attribute__((ext_vector_type(4)));
struct FixPre { v2u st; i32x4t c1[2][2], c0[2][2]; };
template <int WHICH> __device__ __forceinline__ FixPre fix_pre(int r, int pn, int wc, int fq) {
    unsigned char* const ws = WSB(); const int* const st = (const int*)(ws + WS_STATS) + (WHICH == 1 ? 0 : 2 * MP);
    const int* const cb = (const int*)(ws + WS_CTL + CV_OFF); const int* const c1 = cb + (WHICH == 1 ? CV_C1GU : CV_C1IN); const int* const c0 = cb + (WHICH == 1 ? CV_C0GU : CV_C0IN);
    FixPre p; p.st = *(const v2u*)(st + 2 * r); const int colg = pn * 256 + wc * 32 + 8 * fq;
#pragma unroll
    for (int bj = 0; bj < 2; ++bj)
#pragma unroll
        for (int n = 0; n < 2; ++n) { p.c1[bj][n] = *(const i32x4t*)(c1 + colg + bj * 128 + 4 * n); p.c0[bj][n] = *(const i32x4t*)(c0 + colg + bj * 128 + 4 * n); }
    return p;
}
__device__ __forceinline__ void stats_of(const v2u w, float& mu, float& rs) { const int sx = (int)w.x, qx = (int)w.y; mu = (float)sx * (1.0f / (65536.0f * 1024.0f)); const float ex2 = (float)qx * (1.0f / (4096.0f * 1024.0f)); rs = __builtin_amdgcn_rsqf(ex2 - mu * mu + LN_EPS); }
__device__ __forceinline__ f32x4 cvf(const i32x4t v) { return (f32x4){(float)v[0], (float)v[1], (float)v[2], (float)v[3]} * (1.0f / 1048576.0f); }
__device__ __forceinline__ void fix_apply(f32x4 (&acc)[2][2], const FixPre& p) {
    const v2u stw = p.st; float mu, rs; stats_of(stw, mu, rs);
#pragma unroll
    for (int bj = 0; bj < 2; ++bj)
#pragma unroll
        for (int n = 0; n < 2; ++n) { const i32x4t a = p.c1[bj][n], c = p.c0[bj][n]; acc[bj][n] = (acc[bj][n] - cvf(a) * mu) * rs + cvf(c); }
}
template <bool L1> struct TailInProj {
    int dummy;
    struct Pre { FixPre fx; f32x4 c4, s4; };
    __device__ __forceinline__ Pre pre(int r, int pn, int wc, int fq) const {
        Pre p; if (L1) p.fx = fix_pre<2>(r, pn, wc, fq);
        const int kind = pn >> 1; unsigned char* const ws = WSB();
        if (kind == 3 || kind == 4) { const float* const cs = (const float*)(ws + WS_ROPE_C); const float* const sn = (const float*)(ws + WS_ROPE_S); const int d0 = 16 * (wc & 1) + 4 * fq, t = r % 4112;
            p.c4 = *(const f32x4*)(cs + t * 32 + d0); p.s4 = *(const f32x4*)(sn + t * 32 + d0); }
        return p;
    }
    __device__ __forceinline__ void operator()(const f32x4 (&acc_)[2][2], int r, int pn, int wc, int fq, const Pre& p) const {
        f32x4 acc[2][2] = {{acc_[0][0], acc_[0][1]}, {acc_[1][0], acc_[1][1]}}; if (L1) fix_apply(acc, p.fx);
        const int kind = pn >> 1, colt = (pn & 1) * 256; unsigned char* const ws = WSB();
        bf16* base = kind == 0 ? (bf16*)(DOB() + DO_UB) : (bf16*)(ws + (kind == 1 ? WS_UC : kind == 2 ? WS_UH : kind == 3 ? WS_Q : kind == 4 ? WS_K : WS_V));
        if (kind == 3 || kind == 4) {
            const float sc = kind == 3 ? pg8::C2 : 1.0f; const int d0 = 16 * (wc & 1) + 4 * fq;
            const f32x4 c4 = p.c4, s4 = p.s4;
#pragma unroll
            for (int bj = 0; bj < 2; ++bj) { const int G = 2 * bj + (wc >> 1); const f32x4 lo = acc[bj][0], hi = acc[bj][1];
                const f32x4 olo = (lo * c4 - hi * s4) * sc, ohi = (hi * c4 + lo * s4) * sc;
                bf16* pp = base + (size_t)r * 512 + colt + 64 * G + d0;
                v2u a, b; a.x = pg8::cvt_pk_bf16(olo[0], olo[1]); a.y = pg8::cvt_pk_bf16(olo[2], olo[3]); b.x = pg8::cvt_pk_bf16(ohi[0], ohi[1]); b.y = pg8::cvt_pk_bf16(ohi[2], ohi[3]);
                *(v2u*)pp = a; *(v2u*)(pp + 32) = b; }
        } else {
            bf16* rowp = base + (size_t)r * 512 + colt + wc * 32 + 8 * fq;
#pragma unroll
            for (int bj = 0; bj < 2; ++bj) { const f32x4 v0 = acc[bj][0], v1 = acc[bj][1];
                v4u w; w.x = pg8::cvt_pk_bf16(v0[0], v0[1]); w.y = pg8::cvt_pk_bf16(v0[2], v0[3]); w.z = pg8::cvt_pk_bf16(v1[0], v1[1]); w.w = pg8::cvt_pk_bf16(v1[2], v1[3]);
                *(v4u*)(rowp + bj * 128) = w; }
        }
    }
};
template <int MODE> struct TailResid {
    int dummy;
    struct Pre { v4u h0, h1; v2u st; f32x4 gg[2][2], bb[2][2]; };
    __device__ __forceinline__ Pre pre(int r, int pn, int wc, int fq) const {
        unsigned char* const ws = WSB(); const bf16* const X = (const bf16*)(ws + WS_H);
        const int* const sti = (const int*)(ws + WS_STATS) + (MODE == 1 ? 0 : 2 * MP);
        const float* const lg = kargs()->in[MODE == 1 ? 12 : 14]; const float* const lb = kargs()->in[MODE == 1 ? 13 : 15];
        const int col0 = pn * 256 + wc * 32 + 8 * fq; const size_t off = (size_t)r * 1024 + col0;
        Pre p; p.h0 = *(const v4u*)(X + off); p.h1 = *(const v4u*)(X + off + 128);
        if (MODE != 0) { p.st = *(const v2u*)(sti + 2 * r);
#pragma unroll
            for (int bj = 0; bj < 2; ++bj)
#pragma unroll
                for (int n = 0; n < 2; ++n) { p.gg[bj][n] = *(const f32x4*)(lg + col0 + bj * 128 + 4 * n); p.bb[bj][n] = *(const f32x4*)(lb + col0 + bj * 128 + 4 * n); } }
        return p;
    }
    __device__ __forceinline__ void operator()(const f32x4 (&acc)[2][2], int r, int pn, int wc, int fq, const Pre& p) const {
        unsigned char* const ws = WSB(); bf16* const X = (bf16*)(ws + WS_H); bf16* const P = MODE == 2 ? (bf16*)(ws + WS_PRE) : X;
        int* const sto = (int*)(ws + WS_STATS) + (MODE == 0 ? 0 : 2 * MP);
        const int col0 = pn * 256 + wc * 32 + 8 * fq; const size_t off = (size_t)r * 1024 + col0;
        f32x4 gg[2][2], bb[2][2]; float mu = 0.f, rs = 1.f;
        if (MODE != 0) { const v2u stw = p.st; stats_of(stw, mu, rs);
#pragma unroll
            for (int bj = 0; bj < 2; ++bj)
#pragma unroll
                for (int n = 0; n < 2; ++n) { gg[bj][n] = p.gg[bj][n]; bb[bj][n] = p.bb[bj][n]; } }
        float s = 0.f, q = 0.f; v4u w0, w1; v2u e0, e1; const v4u h0 = p.h0, h1 = p.h1;
        pg8::resid8<MODE, false>(h0, acc[0][0], acc[0][1], mu, rs, gg[0], bb[0], s, q, w0, e0); pg8::resid8<MODE, false>(h1, acc[1][0], acc[1][1], mu, rs, gg[1], bb[1], s, q, w1, e1);
        *(v4u*)(P + off) = w0; *(v4u*)(P + off + 128) = w1;
        if (MODE != 2) { s += __shfl_xor(s, 16); s += __shfl_xor(s, 32); q += __shfl_xor(q, 16); q += __shfl_xor(q, 32);
            if (fq < 2) __hip_atomic_fetch_add(sto + 2 * r + fq, fq == 0 ? __float2int_rn(s * 65536.0f) : __float2int_rn(q * 4096.0f), __ATOMIC_RELAXED, __HIP_MEMORY_SCOPE_AGENT); }
    }
};
struct TailSwiGLU {
    int dummy;
    struct Pre { FixPre fx; };
    __device__ __forceinline__ Pre pre(int r, int pn, int wc, int fq) const { Pre p; p.fx = fix_pre<1>(r, pn, wc, fq); return p; }
    __device__ __forceinline__ void operator()(const f32x4 (&acc_)[2][2], int r, int pn, int wc, int fq, const Pre& p) const {
        f32x4 acc[2][2] = {{acc_[0][0], acc_[0][1]}, {acc_[1][0], acc_[1][1]}}; fix_apply(acc, p.fx);
        bf16* const O = (bf16*)(WSB() + WS_ACT0);
        const f32x4 g0 = acc[0][0], g1 = acc[0][1], u0 = acc[1][0], u1 = acc[1][1];
        v4u w; w.x = pg8::cvt_pk_bf16(pg8::silu_mul(g0[0], u0[0]), pg8::silu_mul(g0[1], u0[1])); w.y = pg8::cvt_pk_bf16(pg8::silu_mul(g0[2], u0[2]), pg8::silu_mul(g0[3], u0[3]));
        w.z = pg8::cvt_pk_bf16(pg8::silu_mul(g1[0], u1[0]), pg8::silu_mul(g1[1], u1[1])); w.w = pg8::cvt_pk_bf16(pg8::silu_mul(g1[2], u1[2]), pg8::silu_mul(g1[3], u1[3]));
        *(v4u*)(O + (size_t)r * FF0 + pn * 128 + wc * 32 + 8 * fq) = w;
    }
};

struct Frame {
    LAS unsigned char* lds;
    volatile LAS unsigned* MISC;
    gu32* ctl;
    int tid, lane, wave, vcu, G;
};
template <int CTRL> __device__ __forceinline__ float dppf(float v) { return __builtin_bit_cast(float, __builtin_amdgcn_update_dpp(0, __builtin_bit_cast(int, v), CTRL, 0xf, 0xf, true)); }
__device__ __forceinline__ float rdl(float v, int l) { return __builtin_bit_cast(float, __builtin_amdgcn_readlane(__builtin_bit_cast(int, v), l)); }
__device__ __forceinline__ float row_sum16(float v) { v += dppf<0xB1>(v); v += dppf<0x4E>(v); v += dppf<0x141>(v); v += dppf<0x140>(v); return v; }
__device__ __forceinline__ float wave_sum(float v) { v = row_sum16(v); return (rdl(v, 0) + rdl(v, 16)) + (rdl(v, 32) + rdl(v, 48)); }
template <int MAP> __device__ __forceinline__ int map_row(int n, int row_off) {
    if (MAP == 0) return row_off + n;
    if (MAP == 2) return row_off + 256 * (n >> 7) + (n & 127);
    const int pn = n >> 8; if (pn < 6 || pn > 9) return row_off + n;
    const int lc = n & 255, G = lc >> 6, dd = lc & 63, nn = dd >> 5, d = dd & 31, wcl = d >> 4, fq = (d & 15) >> 2, j = d & 3;
    const int bj = G >> 1, wc = (G & 1) * 2 + wcl;
    return row_off + 256 * pn + 128 * bj + 32 * wc + 8 * fq + 4 * nn + j;
}
template <int MAP> __device__ __forceinline__ void cvt_item(const float* W, int K, int N, bf16* WT, int row_off, LAS float* scr, int item, int lane) {
    const int nblk = N / 64, kb = item / nblk, nb = item % nblk, k0 = 64 * kb, n0 = 64 * nb;
    const int nq = lane & 15, kr = lane >> 4;
    const GAS float* wp = (const GAS float*)W + (size_t)(k0 + 2 * kr) * N + n0 + 4 * nq;
    f32x4 tv[16];
#pragma unroll
    for (int jj = 0; jj < 16; ++jj) tv[jj] = __builtin_nontemporal_load((const GAS f32x4*)(wp + (size_t)(8 * (jj >> 1) + (jj & 1)) * N));
    LAS unsigned* su = (LAS unsigned*)scr;
#pragma unroll
    for (int p = 0; p < 8; ++p) { const int kp = 4 * p + kr;
#pragma unroll
        for (int i = 0; i < 4; ++i) su[(4 * nq + i) * 33 + kp] = pk2(tv[2 * p][i], tv[2 * p + 1][i]); }
    LDS_WAIT(); asm volatile("" ::: "memory");
    const int c = lane & 7;
#pragma unroll
    for (int r = 0; r < 8; ++r) { const int n = (lane >> 3) + 8 * r; const LAS unsigned* s = su + n * 33 + 4 * c;
        v4u o; o.x = s[0]; o.y = s[1]; o.z = s[2]; o.w = s[3];
        *(GAS v4u*)(WT + (size_t)map_row<MAP>(n0 + n, row_off) * K + k0 + 8 * c) = o; }
    LDS_WAIT(); asm volatile("" ::: "memory");
}
template <int MAP> __device__ __forceinline__ void cvt_item_ln(const float* W, int K, int N, bf16* WT, int row_off, LAS float* scr, int item, int lane, const float* gv, const float* bv, int* c1, int* c0) {
    const int nblk = N / 64, kb = item / nblk, nb = item % nblk, k0 = 64 * kb, n0 = 64 * nb;
    const int nq = lane & 15, kr = lane >> 4;
    const GAS float* wp = (const GAS float*)W + (size_t)(k0 + 2 * kr) * N + n0 + 4 * nq;
    f32x4 tv[16];
#pragma unroll
    for (int jj = 0; jj < 16; ++jj) tv[jj] = __builtin_nontemporal_load((const GAS f32x4*)(wp + (size_t)(8 * (jj >> 1) + (jj & 1)) * N));
    f32x4 s1 = (f32x4){0.f, 0.f, 0.f, 0.f}, s0 = s1;
#pragma unroll
    for (int jj = 0; jj < 16; ++jj) { const int k = k0 + 2 * kr + 8 * (jj >> 1) + (jj & 1); const float gk = gv[k], bk = bv[k]; s0 += tv[jj] * bk; tv[jj] = tv[jj] * gk; s1 += tv[jj]; }
#pragma unroll
    for (int i = 0; i < 4; ++i) { s1[i] += __shfl_xor(s1[i], 16); s1[i] += __shfl_xor(s1[i], 32); s0[i] += __shfl_xor(s0[i], 16); s0[i] += __shfl_xor(s0[i], 32); }
    if (kr == 0) {
#pragma unroll
        for (int i = 0; i < 4; ++i) { const int d = map_row<MAP>(n0 + 4 * nq + i, row_off);
            __hip_atomic_fetch_add(c1 + d, __float2int_rn(s1[i] * 1048576.0f), __ATOMIC_RELAXED, __HIP_MEMORY_SCOPE_AGENT); __hip_atomic_fetch_add(c0 + d, __float2int_rn(s0[i] * 1048576.0f), __ATOMIC_RELAXED, __HIP_MEMORY_SCOPE_AGENT); } }
    LAS unsigned* su = (LAS unsigned*)scr;
#pragma unroll
    for (int p = 0; p < 8; ++p) { const int kp = 4 * p + kr;
#pragma unroll
        for (int i = 0; i < 4; ++i) su[(4 * nq + i) * 33 + kp] = pk2(tv[2 * p][i], tv[2 * p + 1][i]); }
    LDS_WAIT(); asm volatile("" ::: "memory");
    const int c = lane & 7;
#pragma unroll
    for (int r = 0; r < 8; ++r) { const int n = (lane >> 3) + 8 * r; const LAS unsigned* s = su + n * 33 + 4 * c;
        v4u o; o.x = s[0]; o.y = s[1]; o.z = s[2]; o.w = s[3];
        *(GAS v4u*)(WT + (size_t)map_row<MAP>(n0 + n, row_off) * K + k0 + 8 * c) = o; }
    LDS_WAIT(); asm volatile("" ::: "memory");
}
__device__ __forceinline__ void cvt8_load(const float* W, int N, int item, int lane, f32x4 (&tv)[16]) {
    const int nblk = N / 64, kb = item / nblk, nb = item % nblk, k0 = 64 * kb, n0 = 64 * nb;
    const int nq = lane & 15, kr = lane >> 4;
    const GAS float* wp = (const GAS float*)W + (size_t)(k0 + 4 * kr) * N + n0 + 4 * nq;
#pragma unroll
    for (int jj = 0; jj < 16; ++jj) tv[jj] = __builtin_nontemporal_load((const GAS f32x4*)(wp + (size_t)(16 * (jj >> 2) + (jj & 3)) * N));
}
template <int MAP, bool FOLD = false> __device__ __forceinline__ void cvt8_finish(f32x4 (&tv)[16], int K, int N, unsigned char* WT, int row_off, LAS float* scr, int item, int lane, float scale, const float* gv = nullptr) {
    const int nblk = N / 64, kb = item / nblk, nb = item % nblk, k0 = 64 * kb, n0 = 64 * nb;
    const int nq = lane & 15, kr = lane >> 4;
    if (FOLD) {
#pragma unroll
        for (int jj = 0; jj < 16; ++jj) tv[jj] = tv[jj] * gv[k0 + 4 * kr + 16 * (jj >> 2) + (jj & 3)]; }
    LAS unsigned* su = (LAS unsigned*)scr;
#pragma unroll
    for (int p = 0; p < 4; ++p) { const int kq = 4 * p + kr;
#pragma unroll
        for (int i = 0; i < 4; ++i) su[(4 * nq + i) * 17 + kq] = pk4_fp8(tv[4 * p][i] * scale, tv[4 * p + 1][i] * scale, tv[4 * p + 2][i] * scale, tv[4 * p + 3][i] * scale); }
    LDS_WAIT(); asm volatile("" ::: "memory");
    const int c = lane & 3;
#pragma unroll
    for (int r = 0; r < 4; ++r) { const int n = (lane >> 2) + 16 * r; const LAS unsigned* s = su + n * 17 + 4 * c;
        v4u o; o.x = s[0]; o.y = s[1]; o.z = s[2]; o.w = s[3];
        *(GAS v4u*)(WT + (size_t)map_row<MAP>(n0 + n, row_off) * K + k0 + 16 * c) = o; }
    LDS_WAIT(); asm volatile("" ::: "memory");
}
template <int MAP, bool FOLD = false> __device__ __forceinline__ void cvt_item8(const float* W, int K, int N, unsigned char* WT, int row_off, LAS float* scr, int item, int lane, float scale, const float* gv = nullptr) {
    f32x4 tv[16]; cvt8_load(W, N, item, lane, tv); cvt8_finish<MAP, FOLD>(tv, K, N, WT, row_off, scr, item, lane, scale, gv);
}
__device__ __forceinline__ void ln16(float (&v)[16], const float* g, const float* b, int lane) {
    float s = 0.f;
#pragma unroll
    for (int i = 0; i < 16; ++i) s += v[i];
    const float mean = wave_sum(s) * (1.f / 1024.f); float q = 0.f;
#pragma unroll
    for (int i = 0; i < 16; ++i) { v[i] -= mean; q += v[i] * v[i]; }
    const float rstd = __builtin_amdgcn_rsqf(wave_sum(q) * (1.f / 1024.f) + LN_EPS);
#pragma unroll
    for (int j = 0; j < 2; ++j) { const f32x4 g0 = *(const f32x4*)(g + 8 * lane + 512 * j), g1 = *(const f32x4*)(g + 8 * lane + 512 * j + 4), b0 = *(const f32x4*)(b + 8 * lane + 512 * j), b1 = *(const f32x4*)(b + 8 * lane + 512 * j + 4);
#pragma unroll
        for (int i = 0; i < 4; ++i) { v[8 * j + i] = v[8 * j + i] * rstd * g0[i] + b0[i]; v[8 * j + 4 + i] = v[8 * j + 4 + i] * rstd * g1[i] + b1[i]; } }
}
__device__ __forceinline__ void ln16r(float (&v)[16], const float (&gr)[16], const float (&br)[16]) {
    float s = 0.f;
#pragma unroll
    for (int i = 0; i < 16; ++i) s += v[i];
    const float mean = wave_sum(s) * (1.f / 1024.f); float q = 0.f;
#pragma unroll
    for (int i = 0; i < 16; ++i) { v[i] -= mean; q += v[i] * v[i]; }
    const float rstd = __builtin_amdgcn_rsqf(wave_sum(q) * (1.f / 1024.f) + LN_EPS);
#pragma unroll
    for (int i = 0; i < 16; ++i) v[i] = v[i] * rstd * gr[i] + br[i];
}
__device__ __forceinline__ void load_gb16(float (&gr)[16], const float* g, int lane) {
#pragma unroll
    for (int j = 0; j < 2; ++j) { const f32x4 a = *(const f32x4*)(g + 8 * lane + 512 * j), c = *(const f32x4*)(g + 8 * lane + 512 * j + 4);
        gr[8 * j + 0] = a[0]; gr[8 * j + 1] = a[1]; gr[8 * j + 2] = a[2]; gr[8 * j + 3] = a[3]; gr[8 * j + 4] = c[0]; gr[8 * j + 5] = c[1]; gr[8 * j + 6] = c[2]; gr[8 * j + 7] = c[3]; }
}
__device__ __forceinline__ void load16_bf16(float (&v)[16], const bf16* row, int lane) {
#pragma unroll
    for (int j = 0; j < 2; ++j) { const v4u w = *(const GAS v4u*)(row + 8 * lane + 512 * j);
        v[8 * j + 0] = bflo(w.x); v[8 * j + 1] = bfhi(w.x); v[8 * j + 2] = bflo(w.y); v[8 * j + 3] = bfhi(w.y); v[8 * j + 4] = bflo(w.z); v[8 * j + 5] = bfhi(w.z); v[8 * j + 6] = bflo(w.w); v[8 * j + 7] = bfhi(w.w); }
}
__device__ __forceinline__ void store16_bf16(const float (&v)[16], bf16* row, int lane) {
#pragma unroll
    for (int j = 0; j < 2; ++j) { v4u w; w.x = pk2(v[8 * j + 0], v[8 * j + 1]); w.y = pk2(v[8 * j + 2], v[8 * j + 3]); w.z = pk2(v[8 * j + 4], v[8 * j + 5]); w.w = pk2(v[8 * j + 6], v[8 * j + 7]);
        *(GAS v4u*)(row + 8 * lane + 512 * j) = w; }
}
__device__ __forceinline__ void zero_rows_bf16(bf16* base, int nrows, int ncols, int gw, int NGW, int lane) {
    for (int r = gw; r < nrows; r += NGW) for (int c = 8 * lane; c < ncols; c += 512) *(GAS v4u*)(base + (size_t)r * ncols + c) = (v4u){0u, 0u, 0u, 0u};
}


#ifndef PHSEL
#define PHSEL 0xffff
#endif
#define IN(k) (lo <= (k) && (k) < hi)
#define ING(k, g) (((PHSEL >> (g)) & 1) && IN(k))
#ifndef PROBE_DUP
#define PROBE_DUP 0
#endif
#define REPS(g) (((PROBE_DUP >> (g)) & 1) ? 2 : 1)
#define GRID_BAR(k) do { if (IN((k) + 1)) xcd_barrier(bar); } while (0)
#define PTRS() const int tid = fresh_tid(), lane = tid & 63; (void)tid; (void)lane; unsigned char* const ws = WSB(); unsigned char* const dout = DOB(); \
    bf16* const H = (bf16*)(ws + WS_H); bf16* const Qb = (bf16*)(ws + WS_Q); bf16* const Kb = (bf16*)(ws + WS_K); bf16* const Vb = (bf16*)(ws + WS_V); \
    bf16* const UB = (bf16*)(dout + DO_UB); bf16* const UC = (bf16*)(ws + WS_UC); bf16* const UH = (bf16*)(ws + WS_UH); \
    bf16* const OV = (bf16*)(dout + DO_OV); bf16* const CAT = (bf16*)(ws + WS_CAT); bf16* const PRE = (bf16*)(ws + WS_PRE); \
    float* const ropec = (float*)(ws + WS_ROPE_C); float* const ropes = (float*)(ws + WS_ROPE_S); \
    (void)H; (void)Qb; (void)Kb; (void)Vb; (void)UB; (void)UC; (void)UH; (void)OV; (void)CAT; (void)PRE; (void)ropec; (void)ropes; (void)dout

template <int layer> __device__ __forceinline__ void layer_body(Frame& F, const XcdBarrier& bar, const int lo, const int hi, unsigned char* lds) {
    const int wave = F.wave;
    const int gw = F.vcu * NWAVES + wave, NGW = F.G * NWAVES;
    {
        const int pb = 1 + 6 * layer;
        if (ING(pb, 1)) for (int rep = 0; rep < REPS(1); ++rep) {
            PTRS(); const bf16* const Win_t = (const bf16*)(ws + WS_WIN) + (size_t)layer * DIN * DM;
            pg8::Gemm g{H, Win_t, MMAIN_ROWS, DIN, DM}; pg8::StaticOrder S; S.init(MMAIN_ROWS, DIN, F.G, (int)blockIdx.x);
            if (layer == 1) zero_rows_bf16(Vb + (size_t)M * 512, 384, 512, gw, NGW, lane);
            pg8::EpiInProj<layer == 1> E{F.lds + RING_OFF};
            { const pg8::ListOrder SL = pg8::make_list(F.lds + RING_OFF, S, tid); pg8::gemm_phase<pg8::EpiInProj<layer == 1>, pg8::ListOrder, true, true>(F.lds + RING_OFF, g, SL, E); }
            for (int tr = 0; tr < REPS(14); ++tr) tail_gemm(H, Win_t, DM, DIN / 256, F.vcu, F.G, fresh_tid() & 63, wave, F.lds + RING_OFF, TailInProj<layer == 1>{0});
            GRID_BAR(pb);
        }
        if (ING(pb + 1, 2)) for (int rep = 0; rep < REPS(2); ++rep) {
            PTRS();
            gu32* const qctr = F.ctl + CW_QCTR + 64 * (layer + 2 * rep);
            constexpr int NATT = 17 * 64, NCONV = M / 128, NCONVB = (NCONV + 7) / 8, I_GM = 16 * 56, I_DM = 56 * 16, NCVT_ITEMS = 16 * I_GM + 8 * I_DM, NCVT = NCVT_ITEMS / 128, CVT0 = layer * NCVT;
            constexpr int I_IN = 16 * 48, I_OUT = 16 * 16, I_G0 = 16 * 44, I_D0 = 44 * 16, NW16_ITEMS = I_IN + 2 * I_OUT + 2 * (2 * I_G0 + I_D0), NW16 = (layer == 0) ? NW16_ITEMS / 64 : 0;
            constexpr int NAUX = NCONVB + NW16 + NCVT, NITEMS = NATT + NAUX;
            static_assert(NCVT_ITEMS % 128 == 0 && NW16_ITEMS % 64 == 0 && 3 * NAUX <= NATT, "aux batches");
            const float* const cw = AIN(5) + (size_t)layer * 3 * DCONV;
            unsigned nxt = 0;
            if (tid == 0) nxt = __hip_atomic_fetch_add(qctr, 1u, RLX_AGENT);
            for (;;) {
                if (tid == 0) F.MISC[16] = nxt;
                LDS_WAIT(); __builtin_amdgcn_s_barrier(); asm volatile("" ::: "memory");
                const int qi = (int)F.MISC[16];
                LDS_WAIT(); __builtin_amdgcn_s_barrier(); asm volatile("" ::: "memory");
                if (qi >= NITEMS) break;
                if (tid == 0) nxt = __hip_atomic_fetch_add(qctr, 1u, RLX_AGENT);
                int it = qi - NAUX, aux = -1;
                if (qi < 4 * NAUX) { const int j = qi >> 2, r = qi & 3; if (r == 3) aux = j; else it = 3 * j + r; }
                if (aux >= NCONVB && aux < NCONVB + NW16) {
                    LAS float* scr = (LAS float*)(F.lds + RING_OFF + wave * 16384); const int lane = fresh_tid() & 63;
                    bf16* const Win_t = (bf16*)(ws + WS_WIN); bf16* const Wout_t = (bf16*)(ws + WS_WOUT); bf16* const Wgu0 = (bf16*)(ws + WS_WGU0); bf16* const Wd0 = (bf16*)(ws + WS_WD0);
#pragma unroll 1
                    for (int k = 0; k < 8; ++k) { int g = (aux - NCONVB) * 64 + k * 8 + wave;
                        int* const cvb_ = (int*)(ws + WS_CTL + CV_OFF);
                        if (g < I_IN) { cvt_item_ln<1>(AIN(4) + (size_t)DM * DIN, DM, DIN, Win_t + (size_t)DIN * DM, 0, scr, g, lane, AIN(14), AIN(15), cvb_ + CV_C1IN, cvb_ + CV_C0IN); continue; } g -= I_IN;
                        if (g < 2 * I_OUT) { const int l = g / I_OUT, r = g % I_OUT; cvt_item<0>(AIN(11) + (size_t)l * DM * DM, DM, DM, Wout_t + (size_t)l * DM * DM, 0, scr, r, lane); continue; } g -= 2 * I_OUT;
                        if (g < 2 * I_G0) { const int w = g / I_G0, r = g % I_G0; cvt_item_ln<2>(AIN(16 + w), DM, FF0, Wgu0, 128 * w, scr, r, lane, AIN(12), AIN(13), cvb_ + CV_C1GU, cvb_ + CV_C0GU); continue; } g -= 2 * I_G0;
                        if (g < I_D0) { cvt_item<0>(AIN(18), FF0, DM, Wd0, 0, scr, g, lane); continue; } g -= I_D0;
                        if (g < 2 * I_G0) { const int w = g / I_G0, r = g % I_G0; cvt_item8<2, true>(AIN(16 + w), DM, FF0, ws + WS_WGU0_8, 128 * w, scr, r, lane, WS_GU, AIN(12)); continue; } g -= 2 * I_G0;
                        cvt_item8<0>(AIN(18), FF0, DM, ws + WS_WD0_8, 0, scr, g, lane, WS_DN); }
                } else if (aux >= NCONVB + NW16) {
                    const int cvb = CVT0 + aux - NCONVB - NW16;
                    LAS float* scr = (LAS float*)(F.lds + RING_OFF + wave * 16384); const int lane = fresh_tid() & 63;
                    unsigned char* const Wmgu = ws + WS_WMOE_GU; unsigned char* const Wmd = ws + WS_WMOE_D;
#pragma unroll 1
                    for (int k = 0; k < 8; k += 2) { const int ci = cvb * 64 + k * 8 + wave, cj = ci + 8;
                        f32x4 ta[16], tb[16];
                        if (ci < 16 * I_GM) { const int ew = ci / I_GM, r = ci % I_GM, r2 = cj % I_GM, e = ew >> 1, w = ew & 1; const float* W = AIN(20 + w) + (size_t)e * DM * FFE;
                            cvt8_load(W, FFE, r, lane, ta); cvt8_load(W, FFE, r2, lane, tb);
                            cvt8_finish<2>(ta, DM, FFE, Wmgu, e * 2 * FFE + 128 * w, scr, r, lane, WS_GU); cvt8_finish<2>(tb, DM, FFE, Wmgu, e * 2 * FFE + 128 * w, scr, r2, lane, WS_GU); }
                        else { const int q = ci - 16 * I_GM, e = q / I_DM, r = q % I_DM, r2 = (q + 8) % I_DM; const float* W = AIN(22) + (size_t)e * FFE * DM;
                            cvt8_load(W, DM, r, lane, ta); cvt8_load(W, DM, r2, lane, tb);
                            cvt8_finish<0>(ta, FFE, DM, Wmd, e * DM, scr, r, lane, WS_DN); cvt8_finish<0>(tb, FFE, DM, Wmd, e * DM, scr, r2, lane, WS_DN); } }
                } else if (aux < 0) {
                    const int qb = 16 - (it >> 6), bhc = it & 63, b = bhc >> 3, hc = bhc & 7;
                    if (qb == 16) attn3::attn_tail_unit((long)b * LSEQ, 4096, LSEQ, (const attn3::bf16*)(Qb + hc * 64), (const attn3::bf16*)(Kb + hc * 64), (const attn3::bf16*)(Vb + (hc >> 1) * 128), (attn3::bf16*)(OV + hc * 128), (char*)lds + RING_OFF);
                    else attn3::attn_unit<ATTN_THRL>((long)b * LSEQ, qb, LSEQ, (const attn3::bf16*)(Qb + hc * 64), (const attn3::bf16*)(Kb + hc * 64), (const attn3::bf16*)(Vb + (hc >> 1) * 128), (attn3::bf16*)(OV + hc * 128), (char*)lds + RING_OFF);
                } else {
                    const int lane = fresh_tid() & 63;
                    const int ch = 8 * lane;
                    float w0[8], w1[8], w2[8];
#pragma unroll
                    for (int i = 0; i < 8; ++i) { w0[i] = cw[ch + i]; w1[i] = cw[DCONV + ch + i]; w2[i] = cw[2 * DCONV + ch + i]; }
#pragma unroll 1
                    for (int ck = 0; ck < 8; ++ck) { const int citem = aux * 8 + ck; if (citem >= NCONV) break;
                    const int r0 = citem * 128 + wave * 16, t0 = r0 % LSEQ;
                    float vm1[8], vm2[8];
#pragma unroll
                    for (int i = 0; i < 8; ++i) { vm1[i] = 0.f; vm2[i] = 0.f; }
                    if (t0 >= 2) {
#pragma unroll
                        for (int k = 1; k <= 2; ++k) { const v4u a = *(const GAS v4u*)(UC + (size_t)(r0 - k) * 512 + ch), c = *(const GAS v4u*)(UH + (size_t)(r0 - k) * 512 + ch);
                            float* dst = (k == 1) ? vm1 : vm2;
                            dst[0] = bflo(a.x) * bflo(c.x); dst[1] = bfhi(a.x) * bfhi(c.x); dst[2] = bflo(a.y) * bflo(c.y); dst[3] = bfhi(a.y) * bfhi(c.y);
                            dst[4] = bflo(a.z) * bflo(c.z); dst[5] = bfhi(a.z) * bfhi(c.z); dst[6] = bflo(a.w) * bflo(c.w); dst[7] = bfhi(a.w) * bfhi(c.w); }
                    }
#pragma unroll 1
                    for (int i4 = 0; i4 < 16; i4 += 8) {
                        v4u ua[8], uc[8], ubv[8];
#pragma unroll
                        for (int k = 0; k < 8; ++k) { const size_t ro = (size_t)(r0 + i4 + k) * 512 + ch; ua[k] = *(const GAS v4u*)(UC + ro); uc[k] = *(const GAS v4u*)(UH + ro); ubv[k] = *(const GAS v4u*)(UB + ro); }
#pragma unroll
                        for (int k = 0; k < 8; ++k) { const int i = i4 + k; const v4u a = ua[k], c = uc[k], ub = ubv[k];
                        float v[8], bb[8], y[8];
                        v[0] = bflo(a.x) * bflo(c.x); v[1] = bfhi(a.x) * bfhi(c.x); v[2] = bflo(a.y) * bflo(c.y); v[3] = bfhi(a.y) * bfhi(c.y);
                        v[4] = bflo(a.z) * bflo(c.z); v[5] = bfhi(a.z) * bfhi(c.z); v[6] = bflo(a.w) * bflo(c.w); v[7] = bfhi(a.w) * bfhi(c.w);
                        bb[0] = bflo(ub.x); bb[1] = bfhi(ub.x); bb[2] = bflo(ub.y); bb[3] = bfhi(ub.y); bb[4] = bflo(ub.z); bb[5] = bfhi(ub.z); bb[6] = bflo(ub.w); bb[7] = bfhi(ub.w);
#pragma unroll
                        for (int q = 0; q < 8; ++q) { y[q] = bb[q] * (w0[q] * vm2[q] + w1[q] * vm1[q] + w2[q] * v[q]); vm2[q] = vm1[q]; vm1[q] = v[q]; }
                        v4u o; o.x = pk2(y[0], y[1]); o.y = pk2(y[2], y[3]); o.z = pk2(y[4], y[5]); o.w = pk2(y[6], y[7]);
                        *(GAS v4u*)(CAT + (size_t)(r0 + i) * DM + ch) = o; } }
                    }
                }
            }
            GRID_BAR(pb + 1);
        }
        if (ING(pb + 2, 3)) for (int rep = 0; rep < REPS(3); ++rep) {
            PTRS();
            const float li = layer == 0 ? 0.2f : 0.35550906759f;
            const float a1 = AIN(6)[layer * 64 + lane] * AIN(7)[layer * 64 + lane], a2 = AIN(8)[layer * 64 + lane] * AIN(9)[layer * 64 + lane];
            const float lam = expf(wave_sum(a1)) - expf(wave_sum(a2)) + li;
            const int h = lane >> 4, sub = lane & 15;
            const f32x4 g0 = *(const f32x4*)(AIN(10) + layer * 128 + sub * 8), g1 = *(const f32x4*)(AIN(10) + layer * 128 + sub * 8 + 4);
            for (int m0 = gw; m0 < M; m0 += 4 * NGW) {
                v4u pp[4], qq[4];
#pragma unroll
                for (int k = 0; k < 4; ++k) { const int m = m0 + k * NGW; if (m < M) { pp[k] = *(const GAS v4u*)(OV + (size_t)m * 1024 + h * 256 + sub * 8); qq[k] = *(const GAS v4u*)(OV + (size_t)m * 1024 + h * 256 + 128 + sub * 8); } }
#pragma unroll
                for (int k = 0; k < 4; ++k) { const int m = m0 + k * NGW; if (m < M) { const v4u p = pp[k], q = qq[k];
                float o[8];
                o[0] = bflo(p.x) - lam * bflo(q.x); o[1] = bfhi(p.x) - lam * bfhi(q.x); o[2] = bflo(p.y) - lam * bflo(q.y); o[3] = bfhi(p.y) - lam * bfhi(q.y);
                o[4] = bflo(p.z) - lam * bflo(q.z); o[5] = bfhi(p.z) - lam * bfhi(q.z); o[6] = bflo(p.w) - lam * bflo(q.w); o[7] = bfhi(p.w) - lam * bfhi(q.w);
                float s = 0.f;
#pragma unroll
                for (int i = 0; i < 8; ++i) s += o[i] * o[i];
                s = row_sum16(s);
                const float sc = __builtin_amdgcn_rsqf(s * (1.f / 128.f) + RMS_EPS) * (1.0f - li);
                v4u w; w.x = pk2(o[0] * sc * g0[0], o[1] * sc * g0[1]); w.y = pk2(o[2] * sc * g0[2], o[3] * sc * g0[3]); w.z = pk2(o[4] * sc * g1[0], o[5] * sc * g1[1]); w.w = pk2(o[6] * sc * g1[2], o[7] * sc * g1[3]);
                *(GAS v4u*)(CAT + (size_t)m * DM + 512 + h * 128 + sub * 8) = w; } }
            }
            GRID_BAR(pb + 2);
        }
        if (ING(pb + 3, 4)) for (int rep = 0; rep < REPS(4); ++rep) {
            PTRS(); const bf16* const Wout_t = (const bf16*)(ws + WS_WOUT) + (size_t)layer * DM * DM;
            pg8::Gemm g{CAT, Wout_t, MMAIN_ROWS, DM, DM}; pg8::StaticOrder S; S.init(MMAIN_ROWS, DM, F.G, (int)blockIdx.x);
            constexpr int RM = layer == 0 ? 0 : 2;
            pg8::EpiResid<RM> E{0};
            { const pg8::ListOrder SL = pg8::make_list(F.lds + RING_OFF, S, tid); pg8::gemm_phase<pg8::EpiResid<RM>, pg8::ListOrder, true, true>(F.lds + RING_OFF, g, SL, E); }
            for (int tr = 0; tr < REPS(14); ++tr) tail_gemm(CAT, Wout_t, DM, DM / 256, F.vcu, F.G, fresh_tid() & 63, wave, F.lds + RING_OFF, TailResid<RM>{0});
            GRID_BAR(pb + 3);
        }
        if (layer == 0) {
            if (ING(5, 6)) for (int rep = 0; rep < REPS(6); ++rep) {
                PTRS();
                pg8::Gemm g{(const bf16*)(ws + WS_X8), (const bf16*)(ws + WS_WGU0_8), MMAIN_ROWS, 2 * FF0, DM / 2}; pg8::StaticOrder S; S.init(MMAIN_ROWS, 2 * FF0, F.G, (int)blockIdx.x);
                pg8::EpiSwiGLU E{F.lds + RING_OFF};
                { const pg8::ListOrder SL = pg8::make_list(F.lds + RING_OFF, S, tid); pg8::gemm_phase<pg8::EpiSwiGLU, pg8::ListOrder, true, true, true>(F.lds + RING_OFF, g, SL, E); }
                for (int tr = 0; tr < REPS(14); ++tr) tail_gemm(H, (const bf16*)(ws + WS_WGU0), DM, 2 * FF0 / 256, F.vcu, F.G, fresh_tid() & 63, wave, F.lds + RING_OFF, TailSwiGLU{0});
                GRID_BAR(5);
            }
            if (ING(6, 7)) for (int rep = 0; rep < REPS(7); ++rep) {
                PTRS();
                pg8::Gemm g{(const bf16*)(ws + WS_ACT0), (const bf16*)(ws + WS_WD0_8), MMAIN_ROWS, DM, FF0 / 2}; pg8::StaticOrder S; S.init(MMAIN_ROWS, DM, F.G, (int)blockIdx.x);
                pg8::EpiResid<1> E{0};
                { const pg8::ListOrder SL = pg8::make_list(F.lds + RING_OFF, S, tid); pg8::gemm_phase<pg8::EpiResid<1>, pg8::ListOrder, true, true, true>(F.lds + RING_OFF, g, SL, E); }
                for (int tr = 0; tr < REPS(14); ++tr) tail_gemm((const bf16*)(ws + WS_ACT0), (const bf16*)(ws + WS_WD0), FF0, DM / 256, F.vcu, F.G, fresh_tid() & 63, wave, F.lds + RING_OFF, TailResid<1>{0});
                GRID_BAR(6);
            }
        } else {
#define MPTRS() PTRS(); int* const tokinfo = (int*)(ws + WS_TOKINFO); int* const rowinfo = (int*)(ws + WS_ROWINFO); \
            unsigned char* const ASORT = ws + WS_ASORT; bf16* const OS = (bf16*)(ws + WS_OUTSLOT); unsigned char* const ACTC = dout + DO_ACT; unsigned char* const H8 = ws + WS_H8; (void)H8; \
            (void)tokinfo; (void)rowinfo; (void)ASORT; (void)OS; (void)ACTC
            if (ING(11, 9)) {
                MPTRS();
                const float* g = AIN(12) + DM; const float* b = AIN(13) + DM; const float* Wr = AIN(19);
                LAS float* wl = (LAS float*)(F.lds + RING_OFF);
                for (int idx = tid; idx < DM * NEXP; idx += NTHREADS) { const int k = idx >> 3, e = idx & 7, ln = (k & 511) >> 3, j = k >> 9, i = k & 7;
                    wl[((((j * 8 + i) * 2 + (e >> 2)) * 64 + ln) << 2) + (e & 3)] = Wr[idx]; }
                __syncthreads();
                float gr[16], br[16]; load_gb16(gr, g, lane); load_gb16(br, b, lane);
                for (int base = gw; base < MMAIN; base += 64 * NGW) {
                    int me0 = 0, me1 = 0, mtok = -1; float mg0 = 0.f, mg1 = 0.f;
                    v4u nr0, nr1;
                    { const int m = (base >> 12) * LSEQ + NMETA + (base & 4095); nr0 = *(const GAS v4u*)(PRE + (size_t)m * DM + 8 * lane); nr1 = *(const GAS v4u*)(PRE + (size_t)m * DM + 512 + 8 * lane); }
                    for (int i = 0; i < 64; ++i) { const int tok = base + i * NGW; if (tok >= MMAIN) break;
                        const int m = (tok >> 12) * LSEQ + NMETA + (tok & 4095);
                        float v[16];
                        v[0] = bflo(nr0.x); v[1] = bfhi(nr0.x); v[2] = bflo(nr0.y); v[3] = bfhi(nr0.y); v[4] = bflo(nr0.z); v[5] = bfhi(nr0.z); v[6] = bflo(nr0.w); v[7] = bfhi(nr0.w);
                        v[8] = bflo(nr1.x); v[9] = bfhi(nr1.x); v[10] = bflo(nr1.y); v[11] = bfhi(nr1.y); v[12] = bflo(nr1.z); v[13] = bfhi(nr1.z); v[14] = bflo(nr1.w); v[15] = bfhi(nr1.w);
                        { const int tn = tok + NGW; if (tn < MMAIN && i + 1 < 64) { const int mn = (tn >> 12) * LSEQ + NMETA + (tn & 4095); nr0 = *(const GAS v4u*)(PRE + (size_t)mn * DM + 8 * lane); nr1 = *(const GAS v4u*)(PRE + (size_t)mn * DM + 512 + 8 * lane); } }
                        ln16r(v, gr, br); store16_bf16(v, H + (size_t)m * DM, lane);
#pragma unroll
                        for (int j = 0; j < 2; ++j) { v2u w; w.x = pk4_fp8(v[8 * j], v[8 * j + 1], v[8 * j + 2], v[8 * j + 3]); w.y = pk4_fp8(v[8 * j + 4], v[8 * j + 5], v[8 * j + 6], v[8 * j + 7]);
                            *(GAS v2u*)(H8 + (size_t)tok * DM + 8 * lane + 512 * j) = w; }
                        typedef float f32x2r __attribute__((ext_vector_type(2)));
                        f32x2r lp[4] = {{0.f, 0.f}, {0.f, 0.f}, {0.f, 0.f}, {0.f, 0.f}};
#pragma unroll
                        for (int q = 0; q < 16; ++q) { const f32x4 wa = *(const LAS f32x4*)(wl + (((q * 2 + 0) * 64 + lane) << 2)), wb = *(const LAS f32x4*)(wl + (((q * 2 + 1) * 64 + lane) << 2));
                            const f32x2r vv = {v[q], v[q]};
                            lp[0] += vv * (f32x2r){wa[0], wa[1]}; lp[1] += vv * (f32x2r){wa[2], wa[3]}; lp[2] += vv * (f32x2r){wb[0], wb[1]}; lp[3] += vv * (f32x2r){wb[2], wb[3]}; }
                        float s4[4];
                        { const float p8[8] = {lp[0].x, lp[0].y, lp[1].x, lp[1].y, lp[2].x, lp[2].y, lp[3].x, lp[3].y};
#pragma unroll
                          for (int a = 0; a < 4; ++a) { auto r = __builtin_amdgcn_permlane32_swap(__float_as_uint(p8[a]), __float_as_uint(p8[a + 4]), false, false); const unsigned r0 = r[0], r1 = r[1]; s4[a] = __uint_as_float(r0) + __uint_as_float(r1); } }
                        float t2[2];
#pragma unroll
                        for (int a = 0; a < 2; ++a) { auto r = __builtin_amdgcn_permlane16_swap(__float_as_uint(s4[a]), __float_as_uint(s4[a + 2]), false, false); const unsigned r0 = r[0], r1 = r[1]; t2[a] = __uint_as_float(r0) + __uint_as_float(r1); }
                        float tot;
                        { const bool b3 = (lane & 8) != 0; const float sel = b3 ? t2[1] : t2[0], oth = b3 ? t2[0] : t2[1];
                          tot = sel + dppf<0x128>(oth);
                          tot += dppf<0xB1>(tot); tot += dppf<0x4E>(tot); tot += dppf<0x141>(tot); }
                        float lg[8];
#pragma unroll
                        for (int e = 0; e < 8; ++e) lg[e] = rdl(tot, 8 * e);
                        int e0 = 0; float v0 = lg[0];
#pragma unroll
                        for (int e = 1; e < 8; ++e) if (lg[e] > v0) { v0 = lg[e]; e0 = e; }
                        int e1 = -1; float v1 = -INFINITY;
#pragma unroll
                        for (int e = 0; e < 8; ++e) if (e != e0 && lg[e] > v1) { v1 = lg[e]; e1 = e; }
                        const float g0 = __builtin_amdgcn_rcpf(1.0f + __builtin_amdgcn_exp2f((v1 - v0) * 1.4426950408889634f));
                        if (lane == i) { me0 = e0; me1 = e1; mtok = tok; mg0 = g0; mg1 = 1.0f - g0; }
                    }
                    const bool valid = mtok >= 0; unsigned mybase = 0; int mycnt = 0; int rank0 = 0, rank1 = 0;
                    const unsigned long long ltmask = (1ull << lane) - 1ull;
#pragma unroll
                    for (int e = 0; e < 8; ++e) { const unsigned long long m0 = __ballot(valid && me0 == e), m1 = __ballot(valid && me1 == e);
                        const int c0 = __popcll(m0), c1 = __popcll(m1);
                        if (lane == e) mycnt = c0 + c1;
                        if (me0 == e) rank0 = __popcll(m0 & ltmask);
                        if (me1 == e) rank1 = c0 + __popcll(m1 & ltmask); }
                    if (lane < 8 && mycnt > 0) mybase = __hip_atomic_fetch_add(F.ctl + CW_CNT + 64 * lane, (unsigned)mycnt, RLX_AGENT);
                    const int p0 = (int)__shfl(mybase, me0) + rank0, p1 = (int)__shfl(mybase, me1) + rank1;
                    if (valid) { typedef int i32x2v __attribute__((ext_vector_type(2)));
                        *(GAS i32x2v*)(rowinfo + 2 * ((size_t)me0 * MOE_CAPR + p0)) = (i32x2v){mtok * 2, __builtin_bit_cast(int, mg0)};
                        *(GAS i32x2v*)(rowinfo + 2 * ((size_t)me1 * MOE_CAPR + p1)) = (i32x2v){mtok * 2 + 1, __builtin_bit_cast(int, mg1)}; }
                }
                GRID_BAR(11);
            }
            int T = 0;
            if (hi > 12) {
                int te[8];
#pragma unroll
                for (int e = 0; e < 8; ++e) { const unsigned c = __hip_atomic_load(F.ctl + CW_CNT + 64 * e, RLX_AGENT); T += (int)((c + 255u) >> 8); te[e] = T; }
                if (threadIdx.x == 0) {
#pragma unroll
                    for (int e = 0; e < 8; ++e) F.MISC[32 + e] = (unsigned)te[e]; }
                __syncthreads();
                T = __builtin_amdgcn_readfirstlane((int)F.MISC[39]);
            }
#define TE(k) ((int)F.MISC[32 + (k)])
#pragma unroll 1
            for (int c = 0; c < MOE_NCH; ++c) {
                const int t0 = c * MOE_CH; const int ntl = c == 0 ? (T < MOE_CH ? T : MOE_CH) : (T > MOE_CH ? T - MOE_CH : 0);
                if (ING(13 + 2 * c, 11)) for (int rep = 0; rep < REPS(11); ++rep) {
                    MPTRS();
                    pg8::Gemm g{(const bf16*)H8, (const bf16*)(ws + WS_WMOE_GU), 0, 0, DM / 2, rowinfo};
                    pg8::MoeOrder<true> S{F.lds, t0, ntl, 28, F.G, (int)blockIdx.x};
                    pg8::EpiSwiGLU8 E{F.lds, t0};
                    { const pg8::ListOrder SL = pg8::make_list(F.lds + RING_OFF, S, tid); pg8::gemm_phase<pg8::EpiSwiGLU8, pg8::ListOrder, MOE_ALIGN, MOE_SP2, true, true>(F.lds + RING_OFF, g, SL, E); }
                    GRID_BAR(13 + 2 * c);
                }
                if (ING(14 + 2 * c, 12)) for (int rep = 0; rep < REPS(12); ++rep) {
                    MPTRS();
                    pg8::Gemm g{(const bf16*)ACTC, (const bf16*)(ws + WS_WMOE_D), 0, 0, FFE / 2};
                    pg8::EpiMoeDown E{F.lds, t0};
                    const int nwg = ntl * 4, R = nwg / F.G, left = nwg - R * F.G;
                    if (left > 0 && left <= 32) {
                        { pg8::MoeOrder<false> S{F.lds, t0, ntl, 4, F.G, (int)blockIdx.x, 0, R};
                          const pg8::ListOrder SL = pg8::make_list(F.lds + RING_OFF, S, tid); pg8::gemm_phase<pg8::EpiMoeDown, pg8::ListOrder, true, MOE_SP2, true>(F.lds + RING_OFF, g, SL, E); }
                        float* const part = (float*)(ws + WS_PART);
                        { pg8::MoeOrder<false> S{F.lds, t0, ntl, 4, F.G, (int)blockIdx.x, 0, 1 << 30, R * F.G};
                          pg8::Gemm gs{(const bf16*)ACTC, (const bf16*)(ws + WS_WMOE_D), (FFE / 128) / pg8::MOE_NSL, 0, FFE / 2};
                          pg8::EpiPartial EP{part};
                          const pg8::ListOrder SL = pg8::make_list(F.lds + RING_OFF, S, tid); pg8::gemm_phase<pg8::EpiPartial, pg8::ListOrder, true, MOE_SP2, true, false, true>(F.lds + RING_OFF, gs, SL, EP); }
                        xcd_barrier(bar);
                        {
                          const pg8::MoeOrder<false> S{F.lds, t0, ntl, 4, F.G, 0, 0, 1 << 30, R * F.G};
                          const int ltid = fresh_tid(), lw = ltid >> 6, ll = ltid & 63, wr = lw >> 2, wc = lw & 3, fr = ll & 15, fq = ll >> 4;
                          bf16* const OSb = (bf16*)(ws + WS_OUTSLOT);
                          for (int it = (int)blockIdx.x; it < left * 16; it += F.G) { const int ul = it >> 4, q = it & 15, ai = q >> 3, bj = (q >> 2) & 1, m = q & 3;
                              int pml, pc, e, pte; S.decode(R * F.G + ul, pml, pc, e, pte); const int tg = t0 + pml;
                              f32x4 s0 = (f32x4){0.f, 0.f, 0.f, 0.f}, s1 = s0;
                              const float* pb = part + (size_t)(ul * pg8::MOE_NSL) * 65536 + (size_t)(q * 2) * 2048 + 4 * ltid;
                              f32x4 p0[pg8::MOE_NSL], p1[pg8::MOE_NSL];
#pragma unroll
                              for (int sl = 0; sl < pg8::MOE_NSL; ++sl) { p0[sl] = *(const GAS f32x4*)(pb + (size_t)sl * 65536); p1[sl] = *(const GAS f32x4*)(pb + (size_t)sl * 65536 + 2048); }
#pragma unroll
                              for (int sl = 0; sl < pg8::MOE_NSL; ++sl) { s0 += p0[sl]; s1 += p1[sl]; }
                              const int vrow = (e * MOE_CAPT + (tg - pte)) * 256 + ai * 128 + wr * 64 + m * 16 + fr;
                              const v2u ri = *(const GAS v2u*)(rowinfo + 2 * vrow); const unsigned rx = ri.x, ry = ri.y; const int ts = (int)rx; const float gt = __uint_as_float(ry) * (OS_SC / WS_DN);
                              if (ts >= 0) { unsigned char* rowp = (unsigned char*)OSb + ((size_t)(ts & 1) * MMAIN + (size_t)(ts >> 1)) * 1024 + pc * 256 + bj * 128 + wc * 32 + 8 * fq;
                                  const f32x4 v0 = s0 * gt, v1 = s1 * gt;
                                  v2u w; w.x = pk4_fp8(v0[0], v0[1], v0[2], v0[3]); w.y = pk4_fp8(v1[0], v1[1], v1[2], v1[3]);
                                  *(GAS v2u*)rowp = w; } } }
                    } else {
                        pg8::MoeOrder<false> S{F.lds, t0, ntl, 4, F.G, (int)blockIdx.x};
                        const pg8::ListOrder SL = pg8::make_list(F.lds + RING_OFF, S, tid); pg8::gemm_phase<pg8::EpiMoeDown, pg8::ListOrder, true, MOE_SP2, true>(F.lds + RING_OFF, g, SL, E);
                    }
                    GRID_BAR(14 + 2 * c);
                }
            }
            if (ING(17, 13)) for (int rep = 0; rep < REPS(13); ++rep) {
                MPTRS();
                const float* g = AIN(14) + DM; const float* b = AIN(15) + DM;
                v4u rh[2][2]; v2u ra[2][2], rb[2][2];
#define FIN_ISSUE(T0) do { _Pragma("unroll") for (int q = 0; q < 2; ++q) { const int tok = (T0) + q * NGW; if (tok < MMAIN) { const int m = (tok >> 12) * LSEQ + NMETA + (tok & 4095); \
                    _Pragma("unroll") for (int j = 0; j < 2; ++j) { rh[q][j] = *(const GAS v4u*)(H + (size_t)m * DM + 8 * lane + 512 * j); ra[q][j] = *(const GAS v2u*)((const unsigned char*)OS + (size_t)tok * DM + 8 * lane + 512 * j); \
                        rb[q][j] = *(const GAS v2u*)((const unsigned char*)OS + ((size_t)MMAIN + tok) * DM + 8 * lane + 512 * j); } } } } while (0)
#define FIN_UNPK(dst, W_, j) do { dst[8 * (j) + 0] = bflo(W_.x); dst[8 * (j) + 1] = bfhi(W_.x); dst[8 * (j) + 2] = bflo(W_.y); dst[8 * (j) + 3] = bfhi(W_.y); dst[8 * (j) + 4] = bflo(W_.z); dst[8 * (j) + 5] = bfhi(W_.z); dst[8 * (j) + 6] = bflo(W_.w); dst[8 * (j) + 7] = bfhi(W_.w); } while (0)
                float gr[16], br[16]; load_gb16(gr, g, lane); load_gb16(br, b, lane);
#define FIN_UNPK8(dst, W_, j) do { typedef float f32x2u __attribute__((ext_vector_type(2))); const unsigned wx_ = W_.x, wy_ = W_.y; \
                    const f32x2u a_ = __builtin_amdgcn_cvt_pk_f32_fp8((int)wx_, false), b_ = __builtin_amdgcn_cvt_pk_f32_fp8((int)wx_, true), c_ = __builtin_amdgcn_cvt_pk_f32_fp8((int)wy_, false), d_ = __builtin_amdgcn_cvt_pk_f32_fp8((int)wy_, true); \
                    dst[8 * (j) + 0] = a_.x * (1.0f / OS_SC); dst[8 * (j) + 1] = a_.y * (1.0f / OS_SC); dst[8 * (j) + 2] = b_.x * (1.0f / OS_SC); dst[8 * (j) + 3] = b_.y * (1.0f / OS_SC); \
                    dst[8 * (j) + 4] = c_.x * (1.0f / OS_SC); dst[8 * (j) + 5] = c_.y * (1.0f / OS_SC); dst[8 * (j) + 6] = d_.x * (1.0f / OS_SC); dst[8 * (j) + 7] = d_.y * (1.0f / OS_SC); } while (0)
                FIN_ISSUE(gw);
                for (int tok0 = gw; tok0 < MMAIN; tok0 += 2 * NGW) {
                    float v[2][16];
#pragma unroll
                    for (int q = 0; q < 2; ++q) { float s0[16], s1[16];
#pragma unroll
                        for (int j = 0; j < 2; ++j) { const v4u wh = rh[q][j]; const v2u wa = ra[q][j], wb = rb[q][j]; FIN_UNPK(v[q], wh, j); FIN_UNPK8(s0, wa, j); FIN_UNPK8(s1, wb, j); }
#pragma unroll
                        for (int i = 0; i < 16; ++i) v[q][i] = ALPHA * v[q][i] + (s0[i] + s1[i]); }
                    if (tok0 + 2 * NGW < MMAIN) FIN_ISSUE(tok0 + 2 * NGW);
#pragma unroll
                    for (int q = 0; q < 2; ++q) { const int tok = tok0 + q * NGW; if (tok < MMAIN) {
                        ln16r(v[q], gr, br);
                        float* orow = (float*)dout + (size_t)tok * DM;
#pragma unroll
                        for (int j = 0; j < 2; ++j) { *(GAS f32x4*)(orow + 8 * lane + 512 * j) = (f32x4){v[q][8 * j], v[q][8 * j + 1], v[q][8 * j + 2], v[q][8 * j + 3]}; *(GAS f32x4*)(orow + 8 * lane + 512 * j + 4) = (f32x4){v[q][8 * j + 4], v[q][8 * j + 5], v[q][8 * j + 6], v[q][8 * j + 7]}; } } }
                }
#undef FIN_ISSUE
#undef FIN_UNPK
#undef FIN_UNPK8
                if (rep + 1 < REPS(13)) xcd_barrier(bar);
            }
        }
    }
}

__global__ void __launch_bounds__(NTHREADS, 2) hybrid_fwd(Args args_unused) {
    extern __shared__ __attribute__((aligned(16))) unsigned char lds[];
    Frame F;
    F.lds = (LAS unsigned char*)lds;
    F.MISC = (volatile LAS unsigned*)(F.lds + MISC_OFF);
    F.tid = threadIdx.x; F.lane = F.tid & 63; F.wave = __builtin_amdgcn_readfirstlane(F.tid >> 6);
    F.G = gridDim.x; { const int bx = blockIdx.x; F.vcu = (F.G % 8 == 0) ? (bx % 8) * (F.G / 8) + bx / 8 : bx; }
    F.ctl = (gu32*)(WSB() + WS_CTL);
    const int wave = F.wave;
    const int gw = F.vcu * NWAVES + wave, NGW = F.G * NWAVES;
    for (int u = F.tid; u < (LDS_BYTES - LDSCTL_OFF) / 4; u += NTHREADS) ((LAS unsigned*)(F.lds + LDSCTL_OFF))[u] = 0u;
    __syncthreads();
#if MK_PER_PHASE
    const int lo = kargs()->ph_lo, hi = kargs()->ph_hi;
#else
    constexpr int lo = 0, hi = NPHASES;
#endif
    const bool one_launch = (lo == 0 && hi == NPHASES);
    XcdBarrier bar; bar.bar = (unsigned*)(F.ctl + CW_BAR); bar.x = 0; bar.st = nullptr;
    if (one_launch) bar = xcd_barrier_post((unsigned*)(F.ctl + CW_BAR), F.MISC + 8);


    if (ING(0, 0)) for (int rep = 0; rep < REPS(0); ++rep) {
        PTRS(); const float* const x = AIN(0); const float* const meta = AIN(1);
        LAS float* scr = (LAS float*)(F.lds + RING_OFF + wave * 16384);
        bf16* const Win_t = (bf16*)(ws + WS_WIN); bf16* const Wout_t = (bf16*)(ws + WS_WOUT); bf16* const Wgu0 = (bf16*)(ws + WS_WGU0); bf16* const Wd0 = (bf16*)(ws + WS_WD0);
        unsigned char* const Wmgu = ws + WS_WMOE_GU; unsigned char* const Wmd = ws + WS_WMOE_D;
        constexpr int I_IN = 16 * 48, I_OUT = 16 * 16, I_G0 = 16 * 44, I_D0 = 44 * 16, I_GM = 16 * 56, I_DM = 56 * 16;
        constexpr int N0 = 2 * I_IN, N1 = N0 + 2 * I_OUT, N2 = N1 + 2 * I_G0, N3 = N2 + I_D0, N4 = N3 + 16 * I_GM, N5 = N4 + 8 * I_DM;
        for (int cr = 0; cr < REPS(15); ++cr)
        for (int it = gw; it < I_IN; it += NGW) {
            if (it < N0) { const int l = it / I_IN, r = it % I_IN; cvt_item<1>(AIN(4) + (size_t)l * DM * DIN, DM, DIN, Win_t + (size_t)l * DIN * DM, 0, scr, r, lane); }
            else if (it < N1) { const int q = it - N0, l = q / I_OUT, r = q % I_OUT; cvt_item<0>(AIN(11) + (size_t)l * DM * DM, DM, DM, Wout_t + (size_t)l * DM * DM, 0, scr, r, lane); }
            else if (it < N2) { const int q = it - N1, w = q / I_G0, r = q % I_G0; cvt_item<2>(AIN(16 + w), DM, FF0, Wgu0, 128 * w, scr, r, lane); }
            else if (it < N3) { const int r = it - N2; cvt_item<0>(AIN(18), FF0, DM, Wd0, 0, scr, r, lane); }
#if 0
            else if (it < N4) { const int q = it - N3, ew = q / I_GM, r = q % I_GM, e = ew >> 1, w = ew & 1; cvt_item8<2>(AIN(20 + w) + (size_t)e * DM * FFE, DM, FFE, Wmgu, e * 2 * FFE + 128 * w, scr, r, lane, WS_GU); }
            else { const int q = it - N4, e = q / I_DM, r = q % I_DM; cvt_item8<0>(AIN(22) + (size_t)e * FFE * DM, FFE, DM, Wmd, e * DM, scr, r, lane, WS_DN); }
#endif
        }
        for (int i = blockIdx.x * NTHREADS + tid; i < LSEQ * 32; i += F.G * NTHREADS) { const int t = i >> 5, d = i & 31;
            double inv = 1.0; for (int k = 0; k < d; ++k) inv *= 0.7498942093324558273;
            const double rev = (double)t * inv * 0.15915494309189533577; const float fr = (float)(rev - __builtin_rint(rev));
            ropec[i] = __builtin_amdgcn_cosf(fr); ropes[i] = __builtin_amdgcn_sinf(fr); }
        for (int er = 0; er < REPS(16); ++er) {
        float gr[16], br[16]; load_gb16(gr, AIN(2), lane); load_gb16(br, AIN(3), lane);
        f32x4 nr[2][4];
#define EMB_ISSUE(M0) do { _Pragma("unroll") for (int q = 0; q < 2; ++q) { const int m = (M0) + q * NGW; if (m < M) { const int b = m / LSEQ, t = m % LSEQ; const float* src = t < NMETA ? meta + (size_t)t * DM : x + ((size_t)b * SEQ + (t - NMETA)) * DM; \
            _Pragma("unroll") for (int j = 0; j < 2; ++j) { nr[q][2 * j] = *(const GAS f32x4*)(src + 8 * lane + 512 * j); nr[q][2 * j + 1] = *(const GAS f32x4*)(src + 8 * lane + 512 * j + 4); } } } } while (0)
        EMB_ISSUE(gw);
        for (int m0 = gw; m0 < M; m0 += 2 * NGW) { float v[2][16];
#pragma unroll
            for (int q = 0; q < 2; ++q)
#pragma unroll
                for (int j = 0; j < 2; ++j) { const f32x4 a = nr[q][2 * j], c = nr[q][2 * j + 1];
                    v[q][8 * j + 0] = a[0]; v[q][8 * j + 1] = a[1]; v[q][8 * j + 2] = a[2]; v[q][8 * j + 3] = a[3]; v[q][8 * j + 4] = c[0]; v[q][8 * j + 5] = c[1]; v[q][8 * j + 6] = c[2]; v[q][8 * j + 7] = c[3]; }
            if (m0 + 2 * NGW < M) EMB_ISSUE(m0 + 2 * NGW);
#pragma unroll
            for (int q = 0; q < 2; ++q) { const int m = m0 + q * NGW; if (m < M) { ln16r(v[q], gr, br); store16_bf16(v[q], H + (size_t)m * DM, lane); } } }
#undef EMB_ISSUE
        }
        zero_rows_bf16(H + (size_t)M * DM, MP - M, DM, gw, NGW, lane);
        zero_rows_bf16(Vb + (size_t)M * 512, 384, 512, gw, NGW, lane);
        { typedef int i32x4v __attribute__((ext_vector_type(4)));
          i32x4v* const rt = (i32x4v*)(ws + WS_ROWINFO);
          for (int i = blockIdx.x * NTHREADS + tid; i < NEXP * MOE_CAPR / 2; i += F.G * NTHREADS) rt[i] = (i32x4v){-1, 0, -1, 0}; }
        GRID_BAR(0);
    }

    layer_body<0>(F, bar, lo, hi, lds);
    layer_body<1>(F, bar, lo, hi, lds);
#undef IN
#undef GRID_BAR
}

extern "C" void kernel_launch(void* const* d_in, const int* in_sizes, int n_in, void* d_out, int out_size, void* d_ws, size_t ws_size, hipStream_t stream) {
    static int grid = 0;
    if (grid == 0) {
        if (n_in != 23 || in_sizes[0] != MMAIN * DM || out_size != MMAIN * DM || ws_size < WS_END) { fprintf(stderr, "kernel_launch: unexpected shapes: n_in %d in0 %d out %d ws %zu (need %zu); nothing launched\n", n_in, n_in > 0 ? in_sizes[0] : -1, out_size, ws_size, (size_t)WS_END); grid = -1; return; }
        int dev = 0, cus = 0, per_cu = 0;
        if (hipGetDevice(&dev) != hipSuccess || hipDeviceGetAttribute(&cus, hipDeviceAttributeMultiprocessorCount, dev) != hipSuccess) { grid = -1; return; }
        if (hipFuncSetAttribute((const void*)hybrid_fwd, hipFuncAttributeMaxDynamicSharedMemorySize, LDS_BYTES) != hipSuccess) { fprintf(stderr, "kernel_launch: hipFuncSetAttribute failed\n"); grid = -1; return; }
        if (hipOccupancyMaxActiveBlocksPerMultiprocessor(&per_cu, (const void*)hybrid_fwd, NTHREADS, LDS_BYTES) != hipSuccess || per_cu < 1) fprintf(stderr, "kernel_launch: occupancy query reports %d\n", per_cu);
        (void)hipGetLastError();
        grid = cus;
    }
    if (grid < 0) return;
    if (hipMemsetAsync((char*)d_ws + WS_CTL, 0, CTL_ZERO_BYTES + STATS_BYTES, stream) != hipSuccess) return;
    Args a{};
    for (int i = 0; i < 23; ++i) a.in[i] = (const float*)d_in[i];
    a.out = (float*)d_out; a.ws = (unsigned char*)d_ws;
#if MK_PER_PHASE
    for (int p = 0; p < NPHASES; ++p) { a.ph_lo = p; a.ph_hi = p + 1; hipLaunchKernelGGL(hybrid_fwd, dim3(grid), dim3(NTHREADS), LDS_BYTES, stream, a); }
#else
    a.ph_lo = 0; a.ph_hi = NPHASES;
    hipLaunchKernelGGL(hybrid_fwd, dim3(grid), dim3(NTHREADS), LDS_BYTES, stream, a);
#endif
}
```

```cpp
#include <hip/hip_runtime.h>
#include <cstdio>
#include <cstdint>
__device__ __forceinline__ int fresh_tid() { int t = threadIdx.x; asm volatile("" : "+v"(t)); return t; }
#ifndef PROBE_EPI2
#define PROBE_EPI2 0
#endif
namespace pg8 {
#define PG8_LAS __attribute__((address_space(3)))
typedef unsigned short bf16_t;
typedef short bf16x8 __attribute__((ext_vector_type(8)));
typedef float f32x4 __attribute__((ext_vector_type(4)));
typedef unsigned u32x4 __attribute__((ext_vector_type(4)));
typedef int i32x8 __attribute__((ext_vector_type(8)));
constexpr int BM = 256, BK = 64, HALF = 128, HTB = HALF * BK * 2  , STAGE_BYTES = 8 * HTB, NXCD = 8, WGM = 4;

__host__ __device__ __forceinline__ int lds_byte(int r, int c) { const int st = (r >> 4) * 2 + (c >> 5), rr = r & 15, cc = c & 31, ob = rr * 64 + cc * 2; return st * 1024 + (ob ^ (((ob >> 9) & 1) << 5)); }
__host__ __device__ __forceinline__ void stage_rc(int b, int& R, int& C) { const int st = b / 1024, sb = b % 1024, swz = sb ^ (((sb >> 9) & 1) << 5); R = (st >> 1) * 16 + swz / 64; C = (st & 1) * 32 + (swz % 64) / 2; }
__host__ __device__ __forceinline__ int perm32(int rho) { const int n = rho >> 4, i = rho & 15; return 8 * (i >> 2) + 4 * n + (i & 3); }

struct Unit { int pm, pn, pv, pq; };
struct Gemm { const bf16_t* A; const bf16_t* Bt; int M, N, K; const int* gi; const bf16_t* A2; int npm1; };

struct StaticOrder {
    int nM, nN, nwg, G, c;
    __host__ __device__ void init(int M, int N, int G_, int c_) { nM = M / BM; nN = N / BM; nwg = nM * nN; G = G_; c = c_; }
    __host__ __device__ bool next(int i, Unit& u) const {
        const long L = (long)i * G + c; if (L >= nwg) return false;
        int wgid = (int)L; { const int q = nwg / NXCD, r = nwg % NXCD, xcd = wgid % NXCD, off = wgid / NXCD; wgid = (xcd < r ? xcd * (q + 1) : r * (q + 1) + (xcd - r) * q) + off; }
        const int nig = WGM * nN, gid = wgid / nig, fm = gid * WGM, gsz = (nM - fm) < WGM ? (nM - fm) : WGM;
        u.pm = fm + ((wgid % nig) % gsz); u.pn = (wgid % nig) / gsz; return true;
    }
    __host__ __device__ bool next_lane(int i, Unit& u) const { return next(i, u); }
    __device__ __forceinline__ void a_ready(const Unit&) const {}
    __device__ __forceinline__ void done(const Unit&) const {}
};

constexpr int UL_OFF = 136192, UL_MAX = 48;
struct ListOrder {
    PG8_LAS unsigned char* ring;
    __device__ __forceinline__ bool next(int i, Unit& u) const {
        if (i >= UL_MAX) return false;
        typedef int i32x4l __attribute__((ext_vector_type(4))); const i32x4l v = *(const PG8_LAS i32x4l*)(ring + UL_OFF + 16 * i); const int a = v.x, b = v.y, c = v.z, d = v.w;
        if (__builtin_amdgcn_readfirstlane(d) == 0) return false;
        u.pm = __builtin_amdgcn_readfirstlane(a); u.pn = __builtin_amdgcn_readfirstlane(b); u.pv = __builtin_amdgcn_readfirstlane(c); u.pq = __builtin_amdgcn_readfirstlane(d) - 1; return true;
    }
    __device__ __forceinline__ void a_ready(const Unit&) const {}
    __device__ __forceinline__ void done(const Unit&) const {}
};
template <class Sched> __device__ __forceinline__ ListOrder make_list(PG8_LAS unsigned char* ring, const Sched& S, int tid) {
    if (tid < UL_MAX) { Unit u; u.pm = 0; u.pn = 0; u.pv = 0; u.pq = 0; const bool ok = S.next_lane(tid, u);
        typedef int i32x4l __attribute__((ext_vector_type(4))); *(PG8_LAS i32x4l*)(ring + UL_OFF + 16 * tid) = (i32x4l){u.pm, u.pn, u.pv, ok ? u.pq + 1 : 0}; }
    __syncthreads();
    ListOrder L; L.ring = ring; return L;
}


__device__ __forceinline__ unsigned cvt_pk_bf16(float lo, float hi) { unsigned r; asm volatile("v_cvt_pk_bf16_f32 %0, %1, %2" : "=v"(r) : "v"(lo), "v"(hi)); return r; }
template <bool FP8> struct FragSel;
template <> struct FragSel<false> { typedef bf16x8 TA; static constexpr int NA = 4, NK = 2;
    static __device__ __forceinline__ f32x4 mma16(bf16x8 b, bf16x8 a, f32x4 c) { return __builtin_amdgcn_mfma_f32_16x16x32_bf16(b, a, c, 0, 0, 0); }
    static __device__ __forceinline__ f32x4 mma8(bf16x8, bf16x8, f32x4 c) { return c; } };
template <> struct FragSel<true> { typedef i32x8 TA; static constexpr int NA = 4, NK = 1;
    static __device__ __forceinline__ f32x4 mma16(i32x8, i32x8, f32x4 c) { return c; }
    static __device__ __forceinline__ f32x4 mma8(i32x8 b, i32x8 a, f32x4 c) { asm volatile("v_mfma_f32_16x16x128_f8f6f4 %0, %1, %2, %0" : "+v"(c) : "v"(b), "v"(a)); return c; } };
constexpr int PG8_GI_OFF = 132096;
template <class Epi, class Sched, bool ALIGN_EPI = false, bool SP2 = false, bool FP8 = false, bool GATHER = false, bool SPLITK = false>
__device__ __forceinline__ void gemm_phase(PG8_LAS unsigned char* lds, const Gemm g, const Sched& S, const Epi& E) {
    const int tid = fresh_tid(), wid = __builtin_amdgcn_readfirstlane(tid >> 6), lane = tid & 63, wr = wid >> 2, wc = wid & 3, fr = lane & 15, fq = lane >> 4;
    const int K = g.K, nt = SPLITK ? g.M : K / BK;
    unsigned voffA[2], voffB[2];
#pragma unroll
    for (int i = 0; i < 2; ++i) { int R, C; stage_rc(tid * 16 + i * 8192, R, C); const int Rb = Epi::PERM ? ((R & ~31) + perm32(R & 31)) : R;
        voffA[i] = (unsigned)(R * K + C) * 2u; voffB[i] = (unsigned)(Rb * K + C) * 2u; }
    unsigned goC[2][2], goN[2][2];
    (void)goC; (void)goN;
    const size_t kstep = (size_t)(BK * 2);
    const size_t hstep = (size_t)HALF * K * 2;
    const size_t tstep = 2 * hstep;
    const unsigned ldsw = (unsigned)wid * 1024u;
    const int aoff = lds_byte(wr * 64 + fr, fq * 8), boff = lds_byte(wc * 32 + fr, fq * 8);
#define PG8_SA(b, h) (((b) * 2 + (h)) * HTB)
#define PG8_SB(b, h) ((4 + (b) * 2 + (h)) * HTB)
#define PG8_STAGE_A(bufoff, kptr, h, go) do { if constexpr (GATHER) PG8_STAGE(bufoff, kptr, go[h]); else PG8_STAGE(bufoff, (kptr) + (h) * hstep, voffA); } while (0)
#define PG8_STAGE(bufoff, gbase, voff) do { _Pragma("unroll") for (int _i = 0; _i < 2; ++_i) \
        __builtin_amdgcn_global_load_lds((const unsigned*)((const char*)(gbase) + (voff)[_i]), (PG8_LAS unsigned*)(lds + (bufoff) + ldsw + _i * 8192), 16, 0, 0); } while (0)
#define PG8_LD1(dst, base) do { if constexpr (FP8) { const i32x4v lo_ = *(const PG8_LAS i32x4v*)(base), hi_ = *(const PG8_LAS i32x4v*)((base) + 1024); dst[0] = __builtin_shufflevector(lo_, hi_, 0, 1, 2, 3, 4, 5, 6, 7); } \
        else { dst[0] = *(const PG8_LAS typename FragSel<FP8>::TA*)(base); dst[FragSel<FP8>::NK - 1] = *(const PG8_LAS typename FragSel<FP8>::TA*)((base) + 1024); } } while (0)
#define PG8_LDA(dst, b, h) do { _Pragma("unroll") for (int m = 0; m < 4; ++m) PG8_LD1(dst[m], lds + PG8_SA(b, h) + aoff + m * 2048); } while (0)
#define PG8_LDB(dst, b, h) do { _Pragma("unroll") for (int n = 0; n < 2; ++n) PG8_LD1(dst[n], lds + PG8_SB(b, h) + boff + n * 2048); } while (0)
#define PG8_MMA(ai, bj, At, Bt) do { __builtin_amdgcn_s_setprio(1); if constexpr (FP8) { _Pragma("unroll") for (int m = 0; m < 4; ++m) _Pragma("unroll") for (int n = 0; n < 2; ++n) \
        acc[ai][bj][m][n] = FragSel<FP8>::mma8(Bt[n][0], At[m][0], acc[ai][bj][m][n]); } \
      else { _Pragma("unroll") for (int m = 0; m < 4; ++m) _Pragma("unroll") for (int n = 0; n < 2; ++n) _Pragma("unroll") for (int k = 0; k < 2; ++k) \
        acc[ai][bj][m][n] = FragSel<FP8>::mma16(Bt[n][k % FragSel<FP8>::NK], At[m][k % FragSel<FP8>::NK], acc[ai][bj][m][n]); } __builtin_amdgcn_s_setprio(0); } while (0)
#define PG8_WAIT_V(n) asm volatile("s_waitcnt vmcnt(" #n ")" ::: "memory")
#define PG8_WAIT_L(n) asm volatile("s_waitcnt lgkmcnt(" #n ")" ::: "memory")
#define PG8_BAR __builtin_amdgcn_s_barrier()
#define PG8_SCHED __builtin_amdgcn_sched_barrier(0)
    Unit cur, nxt; int ui = 0;
    if (!S.next(0, cur)) return;
    f32x4 acc[2][2][4][2];
#pragma unroll
    for (int a = 0; a < 2; ++a)
#pragma unroll
        for (int b = 0; b < 2; ++b)
#pragma unroll
            for (int m = 0; m < 4; ++m)
#pragma unroll
                for (int n = 0; n < 2; ++n) acc[a][b][m][n] = (f32x4){0.f, 0.f, 0.f, 0.f};
    typedef int i32x4v __attribute__((ext_vector_type(4)));
    typename FragSel<FP8>::TA At[FragSel<FP8>::NA][FragSel<FP8>::NK]; typename FragSel<FP8>::TA B0[2][FragSel<FP8>::NK], B1[2][FragSel<FP8>::NK];
#define PG8_ABASE(pm_) ((g.A2 == nullptr || (pm_) < g.npm1) ? (const char*)g.A + (size_t)(pm_) * tstep : (const char*)g.A2 + (size_t)((pm_) - g.npm1) * tstep)
    const char* cA = GATHER ? (const char*)g.A : PG8_ABASE(cur.pm); const char* cB = (const char*)g.Bt + (size_t)cur.pn * tstep;
    if constexpr (SPLITK) { const size_t ko = (size_t)cur.pv * (size_t)g.M * kstep; cA += ko; cB += ko; }
    if constexpr (GATHER) {
#pragma unroll
        for (int h = 0; h < 2; ++h)
#pragma unroll
            for (int i = 0; i < 2; ++i) { int R, C; stage_rc(tid * 16 + i * 8192, R, C); const int v = g.gi[2 * (cur.pv * BM + h * HALF + R)]; goC[h][i] = (unsigned)(v < 0 ? 0 : v >> 1) * (unsigned)(2 * K) + (unsigned)(2 * C); }
    }
    S.a_ready(cur);
    if constexpr (SP2) {
        PG8_STAGE(PG8_SB(0, 0), cB, voffB); PG8_STAGE(PG8_SB(0, 1), cB + hstep, voffB); PG8_STAGE_A(PG8_SA(0, 0), cA, 0, goC); PG8_STAGE_A(PG8_SA(0, 1), cA, 1, goC);
        if (wr == 1) PG8_BAR;
        PG8_WAIT_V(2); PG8_BAR;
        PG8_STAGE(PG8_SB(1, 0), cB + kstep, voffB); PG8_STAGE_A(PG8_SA(1, 0), cA + kstep, 0, goC); PG8_STAGE(PG8_SB(1, 1), cB + hstep + kstep, voffB);
        PG8_WAIT_V(6); PG8_BAR;
    } else {
        PG8_STAGE(PG8_SB(0, 0), cB, voffB); PG8_STAGE_A(PG8_SA(0, 0), cA, 0, goC); PG8_STAGE(PG8_SB(0, 1), cB + hstep, voffB); PG8_STAGE_A(PG8_SA(0, 1), cA, 1, goC);
        if (wr == 1) PG8_BAR;
        PG8_WAIT_V(4); PG8_BAR;
        PG8_STAGE(PG8_SB(1, 0), cB + kstep, voffB); PG8_STAGE_A(PG8_SA(1, 0), cA + kstep, 0, goC); PG8_STAGE(PG8_SB(1, 1), cB + hstep + kstep, voffB);
        PG8_WAIT_V(6); PG8_BAR;
    }
    for (;;) {
        const bool has_next = S.next(ui + 1, nxt);
        const char* nA = (has_next && !GATHER) ? PG8_ABASE(nxt.pm) + (SPLITK ? (size_t)nxt.pv * (size_t)g.M * kstep : (size_t)0) : cA; const char* nB = has_next ? (const char*)g.Bt + (size_t)nxt.pn * tstep + (SPLITK ? (size_t)nxt.pv * (size_t)g.M * kstep : (size_t)0) : cB;
        if constexpr (GATHER) { if (has_next && wid < 2) __builtin_amdgcn_global_load_lds((const unsigned*)(g.gi + 2 * (nxt.pv * BM + wid * HALF) + 4 * lane), (PG8_LAS unsigned*)(lds + PG8_GI_OFF + wid * 1024), 16, 0, 0); }
        for (int t = 0; t < nt; t += 2) {
            const bool last = (t == nt - 2);
            const char* a1 = cA + (size_t)(t + 1) * kstep;
            const char* a2 = last ? nA : cA + (size_t)(t + 2) * kstep; const char* b2 = last ? nB : cB + (size_t)(t + 2) * kstep;
            const char* a3 = a2 + kstep; const char* b3 = b2 + kstep;
            if (last && has_next) S.a_ready(nxt);
            unsigned gs[2][2]; (void)gs;
            if constexpr (GATHER) {
                if (last && has_next) { const PG8_LAS int* gl = (const PG8_LAS int*)(lds + PG8_GI_OFF);
#pragma unroll
                    for (int h = 0; h < 2; ++h)
#pragma unroll
                        for (int i = 0; i < 2; ++i) { int R, C; stage_rc(tid * 16 + i * 8192, R, C); const int v = gl[2 * (h * HALF + R)]; goN[h][i] = (unsigned)(v < 0 ? 0 : v >> 1) * (unsigned)(2 * K) + (unsigned)(2 * C); } }
#pragma unroll
                for (int h = 0; h < 2; ++h)
#pragma unroll
                    for (int i = 0; i < 2; ++i) gs[h][i] = (last && has_next) ? goN[h][i] : goC[h][i];
            }
            if constexpr (Epi::HASFIX) { if (last) E.prefetch(cur, wid, lane); }
            if constexpr (SP2) {
            PG8_LDB(B0, 0, 0); PG8_LDB(B1, 0, 1); PG8_SCHED; PG8_LDA(At, 0, 0); PG8_STAGE_A(PG8_SA(1, 1), a1, 1, goC);
            PG8_WAIT_V(8); PG8_WAIT_L(0); PG8_BAR; PG8_MMA(0, 0, At, B0); PG8_MMA(0, 1, At, B1); PG8_BAR; PG8_SCHED;
            PG8_LDA(At, 0, 1); PG8_STAGE(PG8_SB(0, 0), b2, voffB); PG8_STAGE(PG8_SB(0, 1), b2 + hstep, voffB); PG8_STAGE_A(PG8_SA(0, 0), a2, 0, gs);
            PG8_WAIT_V(8); PG8_WAIT_L(0); PG8_BAR; PG8_MMA(1, 0, At, B0); PG8_MMA(1, 1, At, B1); PG8_BAR; PG8_SCHED;
            PG8_LDB(B0, 1, 0); PG8_LDB(B1, 1, 1); PG8_SCHED; PG8_LDA(At, 1, 0); PG8_STAGE_A(PG8_SA(0, 1), a2, 1, gs);
            PG8_WAIT_V(8); PG8_WAIT_L(0); PG8_BAR; PG8_MMA(0, 0, At, B0); PG8_MMA(0, 1, At, B1); PG8_BAR; PG8_SCHED;
            PG8_LDA(At, 1, 1); PG8_STAGE(PG8_SB(1, 0), b3, voffB); PG8_STAGE(PG8_SB(1, 1), b3 + hstep, voffB); PG8_STAGE_A(PG8_SA(1, 0), a3, 0, gs);
            PG8_WAIT_V(8); PG8_WAIT_L(0); PG8_BAR; PG8_MMA(1, 0, At, B0); PG8_MMA(1, 1, At, B1); PG8_BAR; PG8_SCHED;
            } else {
            PG8_LDB(B0, 0, 0); PG8_SCHED; PG8_LDA(At, 0, 0); PG8_STAGE_A(PG8_SA(1, 1), a1, 1, goC);
            PG8_WAIT_L(8); PG8_BAR; PG8_WAIT_L(0); PG8_MMA(0, 0, At, B0); PG8_BAR; PG8_SCHED;
            PG8_LDB(B1, 0, 1); PG8_STAGE(PG8_SB(0, 0), b2, voffB);
            PG8_BAR; PG8_WAIT_L(0); PG8_MMA(0, 1, At, B1); PG8_BAR;
            PG8_LDA(At, 0, 1); PG8_STAGE_A(PG8_SA(0, 0), a2, 0, gs);
            PG8_BAR; PG8_WAIT_L(0); PG8_MMA(1, 0, At, B0); PG8_BAR; PG8_SCHED;
            PG8_STAGE(PG8_SB(0, 1), b2 + hstep, voffB);
            PG8_WAIT_V(6); PG8_BAR; PG8_MMA(1, 1, At, B1); PG8_BAR;
            PG8_LDB(B0, 1, 0); PG8_SCHED; PG8_LDA(At, 1, 0); PG8_STAGE_A(PG8_SA(0, 1), a2, 1, gs);
            PG8_WAIT_L(8); PG8_BAR; PG8_WAIT_L(0); PG8_MMA(0, 0, At, B0); PG8_BAR; PG8_SCHED;
            PG8_LDB(B1, 1, 1); PG8_STAGE(PG8_SB(1, 0), b3, voffB);
            PG8_BAR; PG8_WAIT_L(0); PG8_MMA(0, 1, At, B1); PG8_BAR;
            PG8_LDA(At, 1, 1); PG8_STAGE_A(PG8_SA(1, 0), a3, 0, gs);
            PG8_BAR; PG8_WAIT_L(0); PG8_MMA(1, 0, At, B0); PG8_BAR; PG8_SCHED;
            PG8_STAGE(PG8_SB(1, 1), b3 + hstep, voffB);
            PG8_WAIT_V(6); PG8_BAR; PG8_MMA(1, 1, At, B1); PG8_BAR;
            }
        }
        if constexpr (FP8) asm volatile("s_nop 15\n\ts_nop 15" ::: "memory");
        if constexpr (ALIGN_EPI) { if (wr == 0) PG8_BAR; }
        { int pm_ = __builtin_amdgcn_readfirstlane(cur.pm), pn_ = __builtin_amdgcn_readfirstlane(cur.pn); asm volatile("" : "+s"(pm_), "+s"(pn_)); cur.pm = pm_; cur.pn = pn_; }
        if constexpr (!Epi::AFTER_DRAIN) { if constexpr (Epi::HASFIX) E.fix(acc, cur, wr, wc, fr, fq); E(acc, cur, wr, wc, fr, fq); S.done(cur); }
        if (!has_next) break;
#pragma unroll
        for (int a = 0; a < 2; ++a)
#pragma unroll
            for (int b = 0; b < 2; ++b)
#pragma unroll
                for (int m = 0; m < 4; ++m)
#pragma unroll
                    for (int n = 0; n < 2; ++n) acc[a][b][m][n] = (f32x4){0.f, 0.f, 0.f, 0.f};
        cur = nxt; cA = nA; cB = nB; ++ui;
        if constexpr (GATHER) {
#pragma unroll
            for (int h = 0; h < 2; ++h)
#pragma unroll
                for (int i = 0; i < 2; ++i) goC[h][i] = goN[h][i]; }
        if constexpr (ALIGN_EPI) { if (wr == 1) PG8_BAR; }
    }
    PG8_WAIT_V(0);
    if constexpr (!ALIGN_EPI) { if (wr == 0) PG8_BAR; }
    PG8_BAR;
    if constexpr (Epi::AFTER_DRAIN) { E.fused(acc, cur, wr, wc, fr, fq, lds, wid, lane); S.done(cur); }
#undef PG8_SA
#undef PG8_SB
#undef PG8_STAGE
#undef PG8_ABASE
#undef PG8_STAGE_A
#undef PG8_LDA
#undef PG8_LDB
#undef PG8_MMA
#undef PG8_LD1
#undef PG8_WAIT_V
#undef PG8_WAIT_L
#undef PG8_BAR
#undef PG8_SCHED
}
}
#include <hip/hip_bf16.h>
#include <cmath>
namespace attn3 {
using bf16=__hip_bfloat16;
using bf16x8=__attribute__((ext_vector_type(8)))short;
using s16x4=__attribute__((ext_vector_type(4)))short;
using f32x16=__attribute__((ext_vector_type(16)))float;
using u32x4=__attribute__((ext_vector_type(4)))unsigned;
constexpr int D=64,QKP=512,VP=512,OP=1024;
constexpr int NW=8,QBLK=32,QB=QBLK*NW,KVBLK=64;
constexpr int ATTN_UNIT_ROWS=QB;
__device__ __forceinline__ int crow(int r,int hi){return (r&3)+8*(r>>2)+4*hi;}
#define SBAR() __builtin_amdgcn_sched_barrier(0)
__device__ __forceinline__ void cmask(f32x16&p0,f32x16&p1,int jb,int qrel,int hi){
  const float NEG=-INFINITY; int kb=64*jb+4*hi;
  #pragma unroll
  for(int r=0;r<16;++r){int kv=kb+(r&3)+8*(r>>2); if(kv>qrel)p0[r]=NEG; if(kv+32>qrel)p1[r]=NEG;}
}

constexpr int NSLOT=3, SLOTB=8192, SLOTV=16384;
constexpr int LDS_K=0, LDS_V=NSLOT*SLOTB, LDS_WS=LDS_V+NSLOT*SLOTV, LDS_OST=LDS_WS+NW*64*4, LDS_BYTES=LDS_OST+NW*4096;
constexpr float C2=0.125f*1.4426950408889634f;
__device__ __forceinline__ void glds16(const void*gsrc,unsigned lds_dst){unsigned keep;
  asm volatile("s_mov_b32 %0, m0\n\ts_mov_b32 m0, %2\n\ts_nop 0\n\tglobal_load_lds_dwordx4 %1, off\n\ts_mov_b32 m0, %0":"=&s"(keep):"v"(gsrc),"s"(lds_dst):"memory");}
__device__ __forceinline__ float max3f(float a,float b,float c){float r;asm("v_max3_f32 %0, %1, %2, %3":"=v"(r):"v"(a),"v"(b),"v"(c));return r;}
__device__ __forceinline__ float max2f(float a,float b){float r;asm("v_max_f32_e32 %0, %1, %2":"=v"(r):"v"(a),"v"(b));return r;}
__device__ __forceinline__ float fadd_s(float a,float b){float r;asm("v_add_f32_e32 %0, %1, %2":"=v"(r):"v"(a),"v"(b));return r;}
__device__ __forceinline__ float fsub_s(float a,float b){float r;asm("v_sub_f32_e32 %0, %1, %2":"=v"(r):"v"(a),"v"(b));return r;}
typedef float f32x2_t __attribute__((ext_vector_type(2))); typedef __bf16 bf16x2_t __attribute__((ext_vector_type(2)));
__device__ __forceinline__ unsigned cvtpk_s(float lo,float hi){f32x2_t v={lo,hi};bf16x2_t b=__builtin_convertvector(v,bf16x2_t);return __builtin_bit_cast(unsigned,b);}
#define WAIT_BAR(N) asm volatile("s_waitcnt vmcnt(" #N ") lgkmcnt(0)\n\ts_barrier":::"memory")

__device__ __forceinline__ void qkt(f32x16&p0,f32x16&p1,const char*Kslot,const bf16x8*qr,int r32,int hi){ const f32x16 negm=f32x16{};
  const char*kb=Kslot+hi*1024+r32*16;
  #pragma unroll
  for(int d0=0;d0<4;++d0){
    const bf16x8 b0=*reinterpret_cast<const bf16x8*>(kb+d0*2048);
    const bf16x8 b1=*reinterpret_cast<const bf16x8*>(kb+d0*2048+512);
    if(d0==0){p0=__builtin_amdgcn_mfma_f32_32x32x16_bf16(b0,qr[0],negm,0,0,0);p1=__builtin_amdgcn_mfma_f32_32x32x16_bf16(b1,qr[0],negm,0,0,0);}
    else{p0=__builtin_amdgcn_mfma_f32_32x32x16_bf16(b0,qr[d0],p0,0,0,0);p1=__builtin_amdgcn_mfma_f32_32x32x16_bf16(b1,qr[d0],p1,0,0,0);}}
}
typedef __attribute__((address_space(3))) const char* lds_cptr;
typedef short v4i16_t __attribute__((ext_vector_type(4)));
__device__ __forceinline__ void kload8(bf16x8*kf,lds_cptr kp){
  kf[0]=*(const __attribute__((address_space(3))) bf16x8*)(kp);      kf[1]=*(const __attribute__((address_space(3))) bf16x8*)(kp+512);
  kf[2]=*(const __attribute__((address_space(3))) bf16x8*)(kp+2048); kf[3]=*(const __attribute__((address_space(3))) bf16x8*)(kp+2560);
  kf[4]=*(const __attribute__((address_space(3))) bf16x8*)(kp+4096); kf[5]=*(const __attribute__((address_space(3))) bf16x8*)(kp+4608);
  kf[6]=*(const __attribute__((address_space(3))) bf16x8*)(kp+6144); kf[7]=*(const __attribute__((address_space(3))) bf16x8*)(kp+6656);
}
__device__ __forceinline__ void kload2(bf16x8*kf,lds_cptr kp,int j){ kf[2*j]=*(const __attribute__((address_space(3))) bf16x8*)(kp+j*2048); kf[2*j+1]=*(const __attribute__((address_space(3))) bf16x8*)(kp+j*2048+512); }
__device__ __forceinline__ s16x4 vtr(lds_cptr p){ return __builtin_bit_cast(s16x4,__builtin_amdgcn_ds_read_tr16_b64_v4i16((__attribute__((address_space(3))) v4i16_t*)p)); }
__device__ __forceinline__ float rowmax(const f32x16&p0,const f32x16&p1){
  float a=max3f(p0[0],p0[1],p1[0]),b=max3f(p0[2],p0[3],p1[1]);a=max3f(a,p1[2],p1[3]);
  #pragma unroll
  for(int r=4;r<16;r+=4){a=max3f(a,p0[r],p0[r+1]);b=max3f(b,p0[r+2],p0[r+3]);a=max3f(a,p1[r],p1[r+1]);b=max3f(b,p1[r+2],p1[r+3]);}
  const float m=max2f(a,b);
  auto rr=__builtin_amdgcn_permlane32_swap(__float_as_uint(m),__float_as_uint(m),false,false);
  return max2f(__uint_as_float(rr[0]),__uint_as_float(rr[1]));
}
__device__ __forceinline__ void pv(f32x16*o,int vb,bf16x8 pa0,bf16x8 pa1,bf16x8 pa2,bf16x8 pa3){
  #pragma unroll
  for(int d0=0;d0<4;++d0){s16x4 lo[4],hi[4];
    #pragma unroll
    for(int ks=0;ks<4;++ks){
      asm volatile("ds_read_b64_tr_b16 %0,%1 offset:%c2":"=&v"(lo[ks]):"v"(vb),"i"(d0*4096+ks*1024):"memory");
      asm volatile("ds_read_b64_tr_b16 %0,%1 offset:%c2":"=&v"(hi[ks]):"v"(vb),"i"(d0*4096+ks*1024+512):"memory");}
    asm volatile("s_waitcnt lgkmcnt(0)":::"memory");SBAR();
    #define PK(k) (bf16x8){lo[k][0],lo[k][1],lo[k][2],lo[k][3],hi[k][0],hi[k][1],hi[k][2],hi[k][3]}
    o[d0]=__builtin_amdgcn_mfma_f32_32x32x16_bf16(pa0,PK(0),o[d0],0,0,0);
    o[d0]=__builtin_amdgcn_mfma_f32_32x32x16_bf16(pa1,PK(1),o[d0],0,0,0);
    o[d0]=__builtin_amdgcn_mfma_f32_32x32x16_bf16(pa2,PK(2),o[d0],0,0,0);
    o[d0]=__builtin_amdgcn_mfma_f32_32x32x16_bf16(pa3,PK(3),o[d0],0,0,0);
    #undef PK
  }
}

#ifndef ATTN_STORE16
#define ATTN_STORE16(p,v) (*(u32x4*)(p)=(v))
#endif
template<int THRL> __device__ __forceinline__ void attn_unit(long rowbase,int qb,int lseq,const bf16*Q,const bf16*__restrict__ K,const bf16*__restrict__ V,bf16*O,char*shm){
  const int tid=fresh_tid(),lane=tid&63,r32=lane&31,hi=lane>>5; const int wid=__builtin_amdgcn_readfirstlane(tid>>6);
  const int q0=qb*QB;
  const bf16*Qw=Q+(rowbase+q0+wid*QBLK)*QKP;
  const bf16*Kh=K+rowbase*QKP,*Vh=V+rowbase*VP;
  const unsigned lds0=(unsigned)(uintptr_t)shm;
  float*wsf=(float*)(shm+LDS_WS)+wid*64;
  const bf16*ksrc=Kh+(long)lane*QKP+wid*8;
  const bf16*vsrc=Vh+(long)(16*(wid&3)+(lane>>2))*VP+(wid>>2)*32+(lane&3)*8;
  const unsigned kdst=lds0+LDS_K+wid*1024, vdst=lds0+LDS_V+wid*1024;
  #define DMA_K(t,slot) glds16(ksrc+(long)(t)*KVBLK*QKP,(unsigned)__builtin_amdgcn_readfirstlane(kdst+(slot)))
  #define DMA_V(t,slot) do{ glds16(vsrc+(long)(t)*KVBLK*VP,(unsigned)__builtin_amdgcn_readfirstlane(vdst+2*(slot))); glds16(vsrc+(long)(t)*KVBLK*VP+64,(unsigned)__builtin_amdgcn_readfirstlane(vdst+2*(slot)+8192)); }while(0)
  const int vb0=(int)(lds0+LDS_V)+((lane>>4)&1)*32+(lane&3)*8+(4*hi+((lane&15)>>2))*64;
  const char*Kbase=shm+LDS_K; bf16x8 kf[8];
  const lds_cptr shm3=(lds_cptr)shm; const lds_cptr kp0=shm3+LDS_K+hi*1024+r32*16; const lds_cptr vp0=shm3+LDS_V+((lane>>4)&1)*32+(lane&3)*8+(4*hi+((lane&15)>>2))*64;
  const int NT=(q0+QB)/KVBLK;
  DMA_K(0,0);DMA_V(0,0);DMA_K(1,SLOTB);
  bf16x8 qr[4];
  #pragma unroll
  for(int d0=0;d0<4;++d0)qr[d0]=*reinterpret_cast<const bf16x8*>(&Qw[(long)r32*QKP+d0*16+hi*8]);
  float mhat=0.f,l_reg=0.f;f32x16 o[4];o[0]=f32x16{};o[1]=f32x16{};o[2]=f32x16{};o[3]=f32x16{};
  const int qrel=wid*QBLK+r32;
  #define CMASK(P0,P1,t) do{int jb_=(t)-(NT-4); if(jb_>=0)cmask(P0,P1,jb_,qrel,hi);}while(0)
  bool resc=false;
  #define START(P0,P1) do{ const float rm=rowmax(P0,P1); resc=false; \
    { const float dl=rm; mhat=fadd_s(mhat,dl); \
      _Pragma("unroll") for(int r=0;r<16;++r){P0[r]=fsub_s(P0[r],dl);P1[r]=fsub_s(P1[r],dl);} } \
    _Pragma("unroll") for(int r=0;r<16;++r)P0[r]=__builtin_amdgcn_exp2f(P0[r]); }while(0)
  #define RESC() do{ if(resc){ asm volatile("s_waitcnt lgkmcnt(0)":::"memory"); \
      _Pragma("unroll") for(int d_=0;d_<4;++d_) _Pragma("unroll") for(int r=0;r<16;++r)o[d_][r]*=wsf[crow(r,hi)]; } }while(0)
  f32x16 pA0,pA1,pB0,pB1;
  int sl_prev=0,sl_cur=0,sl_next=SLOTB;
  #define ROT() do{sl_prev=sl_cur;sl_cur=sl_next;sl_next=(sl_next==(NSLOT-1)*SLOTB)?0:sl_next+SLOTB;}while(0)
  DMA_K(2,2*SLOTB);
  WAIT_BAR(3);
  qkt(pA0,pA1,Kbase,qr,r32,hi);asm volatile("s_nop 15\n\ts_nop 7":"+v"(pA0),"+v"(pA1));CMASK(pA0,pA1,0);
  START(pA0,pA1);
  _Pragma("unroll") for(int r=0;r<16;++r)pA1[r]=__builtin_amdgcn_exp2f(pA1[r]);
  WAIT_BAR(0);
  DMA_K(3,0);DMA_V(1,SLOTB);
  ROT();
  kload8(kf,kp0+sl_cur);
  WAIT_BAR(3);
  s16x4 vlo[4],vhi[4]; u32x4 pw0,pw1,pw2,pw3;
  #define PKW(P,B) cvtpk_s(P[B],P[B+1])
  #define PAF(k) __builtin_bit_cast(bf16x8,pw##k)
  #define VSL(i) (bf16x8){vlo[i][0],vlo[i][1],vlo[i][2],vlo[i][3],vhi[i][0],vhi[i][1],vhi[i][2],vhi[i][3]}
  #define PIN(x) asm volatile("":"+v"(x))
  #define MX3(a,b,c) __builtin_fmaxf(__builtin_fmaxf((a),(b)),(c))
  #define GAPA(MF,A0,A1,A2,A3,W0,W1,PW) do{ MF; sacc+=A0; sacc+=A1; sacc+=A2; sacc+=A3; PIN(sacc); W0; W1; PIN(PW); SBAR(); }while(0)
  #define EX(v) __builtin_amdgcn_exp2f(v)
  #define GAPB(MF,RD,X,B) do{ MF; RD; X[B]=EX(X[B]-mhat); X[B+1]=EX(X[B+1]-mhat); PIN(X); SBAR(); }while(0)
  #define VRDF(s,f) do{ vlo[s]=vtr(vp_+(((f)>>2)*4096+((f)&3)*1024)); vhi[s]=vtr(vp_+(((f)>>2)*4096+((f)&3)*1024+512)); }while(0)
  #define KRD(G,j) do{ if(G){ kload2(kf,kp0+sl_next,j); SBAR(); } }while(0)
  #define STEP(C0,C1,P0,P1,t,GK,GV,GL) do{ SBAR(); \
    const lds_cptr vp_=vp0+2*sl_prev; \
    float sacc=(P0[0]+P0[1]); \
    GAPA(C0=__builtin_amdgcn_mfma_f32_32x32x16_bf16(kf[0],qr[0],f32x16{},0,0,0), P0[2],P0[3],P0[4],P0[5],     pw0[0]=PKW(P0,0), pw0[1]=PKW(P0,2), pw0); \
    GAPA(C1=__builtin_amdgcn_mfma_f32_32x32x16_bf16(kf[1],qr[0],f32x16{},0,0,0), P0[6],P0[7],P0[8],P0[9],     pw0[2]=PKW(P0,4), pw0[3]=PKW(P0,6), pw0); \
    GAPA(C0=__builtin_amdgcn_mfma_f32_32x32x16_bf16(kf[2],qr[1],C0,0,0,0),   P0[10],P0[11],P0[12],P0[13], pw1[0]=PKW(P0,8), pw1[1]=PKW(P0,10), pw1); \
    GAPA(C1=__builtin_amdgcn_mfma_f32_32x32x16_bf16(kf[3],qr[1],C1,0,0,0),   P0[14],P0[15],P1[0],P1[1],   pw1[2]=PKW(P0,12),pw1[3]=PKW(P0,14), pw1); \
    VRDF(0,0); SBAR(); GAPA(C0=__builtin_amdgcn_mfma_f32_32x32x16_bf16(kf[4],qr[2],C0,0,0,0),   P1[2],P1[3],P1[4],P1[5],     pw2[0]=PKW(P1,0), pw2[1]=PKW(P1,2), pw2); \
    VRDF(1,4); SBAR(); GAPA(C1=__builtin_amdgcn_mfma_f32_32x32x16_bf16(kf[5],qr[2],C1,0,0,0),   P1[6],P1[7],P1[8],P1[9],     pw2[2]=PKW(P1,4), pw2[3]=PKW(P1,6), pw2); \
    VRDF(2,1); SBAR(); GAPA(C0=__builtin_amdgcn_mfma_f32_32x32x16_bf16(kf[6],qr[3],C0,0,0,0),   P1[10],P1[11],P1[12],P1[13], pw3[0]=PKW(P1,8), pw3[1]=PKW(P1,10), pw3); \
    VRDF(3,5); SBAR(); GAPA(C1=__builtin_amdgcn_mfma_f32_32x32x16_bf16(kf[7],qr[3],C1,0,0,0),   P1[14],P1[15],0.f,0.f,       pw3[2]=PKW(P1,12),pw3[3]=PKW(P1,14), pw3); \
    l_reg+=sacc; \
    if(GK){DMA_K((t)+3,sl_cur);} if(GV){DMA_V((t)+1,sl_next);} \
    CMASK(C0,C1,t); \
    { float a=MX3(C0[0],C0[1],C1[0]),b=MX3(C0[2],C0[3],C1[1]); a=MX3(a,C1[2],C1[3]); \
      _Pragma("unroll") for(int r=4;r<16;r+=4){a=MX3(a,C0[r],C0[r+1]);b=MX3(b,C0[r+2],C0[r+3]);a=MX3(a,C1[r],C1[r+1]);b=MX3(b,C1[r+2],C1[r+3]);} \
      float rm=__builtin_fmaxf(a,b); { auto rr=__builtin_amdgcn_permlane32_swap(__float_as_uint(rm),__float_as_uint(rm),false,false); rm=__builtin_fmaxf(__uint_as_float(rr[0]),__uint_as_float(rr[1])); } \
      resc=false; \
      rm-=mhat; \
      if(__builtin_expect(__any(rm>(float)THRL),0)){ const float dl=__builtin_fmaxf(rm,0.f); mhat+=dl; \
        const float f=__builtin_amdgcn_exp2f(-dl); l_reg*=f; if(hi==0)wsf[r32]=f; resc=true; } } \
    SBAR(); \
    GAPB(o[0]=__builtin_amdgcn_mfma_f32_32x32x16_bf16(PAF(0),VSL(0),o[0],0,0,0), VRDF(0,2), C0,0); \
    GAPB(o[1]=__builtin_amdgcn_mfma_f32_32x32x16_bf16(PAF(0),VSL(1),o[1],0,0,0), VRDF(1,6), C0,2); \
    KRD(GL,0); GAPB(o[0]=__builtin_amdgcn_mfma_f32_32x32x16_bf16(PAF(1),VSL(2),o[0],0,0,0), VRDF(2,3), C0,4); \
    KRD(GL,1); GAPB(o[1]=__builtin_amdgcn_mfma_f32_32x32x16_bf16(PAF(1),VSL(3),o[1],0,0,0), VRDF(3,7), C0,6); \
    KRD(GL,2); GAPB(o[0]=__builtin_amdgcn_mfma_f32_32x32x16_bf16(PAF(2),VSL(0),o[0],0,0,0), VRDF(0,8), C0,8); \
    KRD(GL,3); GAPB(o[1]=__builtin_amdgcn_mfma_f32_32x32x16_bf16(PAF(2),VSL(1),o[1],0,0,0), VRDF(1,12), C0,10); \
    GAPB(o[0]=__builtin_amdgcn_mfma_f32_32x32x16_bf16(PAF(3),VSL(2),o[0],0,0,0), VRDF(2,9), C0,12); \
    GAPB(o[1]=__builtin_amdgcn_mfma_f32_32x32x16_bf16(PAF(3),VSL(3),o[1],0,0,0), VRDF(3,13), C0,14); \
    GAPB(o[2]=__builtin_amdgcn_mfma_f32_32x32x16_bf16(PAF(0),VSL(0),o[2],0,0,0), VRDF(0,10), C1,0); \
    GAPB(o[3]=__builtin_amdgcn_mfma_f32_32x32x16_bf16(PAF(0),VSL(1),o[3],0,0,0), VRDF(1,14), C1,2); \
    GAPB(o[2]=__builtin_amdgcn_mfma_f32_32x32x16_bf16(PAF(1),VSL(2),o[2],0,0,0), VRDF(2,11), C1,4); \
    GAPB(o[3]=__builtin_amdgcn_mfma_f32_32x32x16_bf16(PAF(1),VSL(3),o[3],0,0,0), VRDF(3,15), C1,6); \
    GAPB(o[2]=__builtin_amdgcn_mfma_f32_32x32x16_bf16(PAF(2),VSL(0),o[2],0,0,0), (void)0, C1,8); \
    GAPB(o[3]=__builtin_amdgcn_mfma_f32_32x32x16_bf16(PAF(2),VSL(1),o[3],0,0,0), (void)0, C1,10); \
    GAPB(o[2]=__builtin_amdgcn_mfma_f32_32x32x16_bf16(PAF(3),VSL(2),o[2],0,0,0), (void)0, C1,12); \
    GAPB(o[3]=__builtin_amdgcn_mfma_f32_32x32x16_bf16(PAF(3),VSL(3),o[3],0,0,0), (void)0, C1,14); \
    }while(0)
  int t=1;
  #undef CMASK
  #define CMASK(P0,P1,t) do{}while(0)
  for(;t+5<NT;t+=2){
    STEP(pB0,pB1,pA0,pA1,t,true,true,true);     WAIT_BAR(3); RESC(); ROT();
    STEP(pA0,pA1,pB0,pB1,t+1,true,true,true);   WAIT_BAR(3); RESC(); ROT();
  }
  #undef CMASK
  #define CMASK(P0,P1,t) do{int jb_=(t)-(NT-4); if(jb_>=0)cmask(P0,P1,jb_,qrel,hi);}while(0)
  #define ENDW(tt) do{ if((tt)+3<NT){WAIT_BAR(3);} else if((tt)+2<NT){WAIT_BAR(2);} else {WAIT_BAR(0);} }while(0)
  for(;t+1<NT;t+=2){
    STEP(pB0,pB1,pA0,pA1,t,(t+3<NT),(t+1<NT),(t+1<NT));       ENDW(t);   RESC(); ROT();
    STEP(pA0,pA1,pB0,pB1,t+1,(t+4<NT),(t+2<NT),(t+2<NT));     ENDW(t+1); RESC(); ROT();
  }
  STEP(pB0,pB1,pA0,pA1,NT-1,false,false,false); RESC();
  { float sacc=pB0[0]+pB0[1]; _Pragma("unroll") for(int r=2;r<16;++r)sacc+=pB0[r]; _Pragma("unroll") for(int r=0;r<16;++r)sacc+=pB1[r]; l_reg+=sacc;
    pw0=(u32x4){PKW(pB0,0),PKW(pB0,2),PKW(pB0,4),PKW(pB0,6)};pw1=(u32x4){PKW(pB0,8),PKW(pB0,10),PKW(pB0,12),PKW(pB0,14)};pw2=(u32x4){PKW(pB1,0),PKW(pB1,2),PKW(pB1,4),PKW(pB1,6)};pw3=(u32x4){PKW(pB1,8),PKW(pB1,10),PKW(pB1,12),PKW(pB1,14)};
    SBAR(); pv(o,vb0+2*sl_cur,PAF(0),PAF(1),PAF(2),PAF(3)); }
  #undef PKW
  #undef PAF
  #undef VSL
  #undef PIN
  #undef MX3
  #undef GAPA
  #undef GAPB
  #undef EX
  #undef VRDF
  #undef KRD
  #undef STEP
  #undef ENDW
  {auto rr=__builtin_amdgcn_permlane32_swap(__float_as_uint(l_reg),__float_as_uint(l_reg),false,false);l_reg=__uint_as_float(rr[0])+__uint_as_float(rr[1]);}
  if(hi==0)wsf[32+r32]=l_reg;asm volatile("s_waitcnt lgkmcnt(0)":::"memory");
  float rli[16];
  #pragma unroll
  for(int r=0;r<16;++r)rli[r]=__builtin_amdgcn_rcpf(wsf[32+crow(r,hi)]);
  bf16*Ow=O+(rowbase+q0+wid*QBLK)*OP;
  { bf16*stg=(bf16*)(shm+LDS_OST)+wid*2048;
    #pragma unroll
    for(int hf=0;hf<2;++hf){
      #pragma unroll
      for(int r=0;r<16;++r){const int orow=crow(r,hi);
        { const unsigned pk=cvtpk_s(o[2*hf][r]*rli[r],o[2*hf+1][r]*rli[r]); unsigned short*const sg=(unsigned short*)stg;
          sg[orow*64+r32]=(unsigned short)(pk&0xffffu); sg[orow*64+32+r32]=(unsigned short)(pk>>16); } }
      asm volatile("s_waitcnt lgkmcnt(0)":::"memory");
      #pragma unroll
      for(int i=0;i<4;++i){const int row=i*8+(lane>>3),ch=lane&7; const u32x4 v=*(const u32x4*)(stg+row*64+ch*8); if(q0+wid*QBLK+row<lseq)ATTN_STORE16(Ow+(long)row*OP+hf*64+ch*8,v);}
      asm volatile("s_waitcnt lgkmcnt(0)":::"memory"); } }
  asm volatile("s_waitcnt lgkmcnt(0)\n\ts_barrier":::"memory");
  #undef DMA_K
  #undef DMA_V
  #undef CMASK
  #undef START
  #undef RESC
  #undef ROT
}

constexpr int TAIL_SCR=132096;
__device__ __forceinline__ void attn_tail_unit(long rowbase,int q0,int lseq,const bf16*Q,const bf16*__restrict__ K,const bf16*__restrict__ V,bf16*O,char*shm){
  const int tid=fresh_tid(),lane=tid&63,r32=lane&31,hi=lane>>5; const int wid=__builtin_amdgcn_readfirstlane(tid>>6);
  const bf16*Kh=K+rowbase*QKP,*Vh=V+rowbase*VP;
  const unsigned lds0=(unsigned)(uintptr_t)shm; const unsigned vslot_a=lds0+(unsigned)wid*16384u;
  float*const wsf=(float*)(shm+TAIL_SCR)+wid*32; float*const ML=(float*)(shm+TAIL_SCR+1024); float*const SC=(float*)(shm+TAIL_SCR+3072);
  const int nvalid=lseq-q0;
  bf16x8 qr[4];
  #pragma unroll
  for(int d0=0;d0<4;++d0){ qr[d0]=*reinterpret_cast<const bf16x8*>(&Q[(rowbase+q0+(r32<nvalid?r32:0))*QKP+d0*16+hi*8]); if(r32>=nvalid)qr[d0]=bf16x8{}; }
  const int NTK=q0/KVBLK+1;
  float m=-INFINITY,l=0.f; f32x16 o[4]; o[0]=f32x16{};o[1]=f32x16{};o[2]=f32x16{};o[3]=f32x16{};
  const int vb=(int)vslot_a+((lane>>4)&1)*32+(lane&3)*8+(4*hi+((lane&15)>>2))*64;
  bf16x8 kf[8],kn[8];
  { const bf16*kt=Kh+((long)wid*KVBLK+r32)*QKP+hi*8;
    #pragma unroll
    for(int d0=0;d0<4;++d0){ kf[2*d0]=*reinterpret_cast<const bf16x8*>(kt+d0*16); kf[2*d0+1]=*reinterpret_cast<const bf16x8*>(kt+32*QKP+d0*16); } }
  for(int t=wid;t<NTK;t+=NW){
    asm volatile("s_waitcnt vmcnt(0)":::"memory");
    { const bf16*vt=Vh+(long)t*KVBLK*VP+(long)(lane>>2)*VP+(lane&3)*8;
      #pragma unroll
      for(int pw=0;pw<8;++pw){ const bf16*src=vt+(long)(16*(pw&3))*VP+(pw>>2)*32;
        glds16(src,(unsigned)__builtin_amdgcn_readfirstlane(vslot_a+pw*1024)); glds16(src+64,(unsigned)__builtin_amdgcn_readfirstlane(vslot_a+pw*1024+8192)); } }
    { const int tn=(t+NW<NTK)?t+NW:t; const bf16*kt=Kh+((long)tn*KVBLK+r32)*QKP+hi*8;
      #pragma unroll
      for(int d0=0;d0<4;++d0){ kn[2*d0]=*reinterpret_cast<const bf16x8*>(kt+d0*16); kn[2*d0+1]=*reinterpret_cast<const bf16x8*>(kt+32*QKP+d0*16); } }
    asm volatile("":::"memory");
    f32x16 p0=f32x16{},p1=f32x16{};
    #pragma unroll
    for(int d0=0;d0<4;++d0){ p0=__builtin_amdgcn_mfma_f32_32x32x16_bf16(kf[2*d0],qr[d0],p0,0,0,0); p1=__builtin_amdgcn_mfma_f32_32x32x16_bf16(kf[2*d0+1],qr[d0],p1,0,0,0); }
    asm volatile("s_nop 15\n\ts_nop 7":"+v"(p0),"+v"(p1));
    if(t==NTK-1)cmask(p0,p1,0,r32,hi);
    const float rm=rowmax(p0,p1);
    const float mn=__builtin_fmaxf(m,rm); const float f=__builtin_amdgcn_exp2f(m-mn); m=mn; l*=f;
    if(hi==0)wsf[r32]=f;
    float sacc=0.f;
    #pragma unroll
    for(int r=0;r<16;++r){ p0[r]=__builtin_amdgcn_exp2f(p0[r]-mn); p1[r]=__builtin_amdgcn_exp2f(p1[r]-mn); sacc+=p0[r]+p1[r]; }
    l+=sacc;
    asm volatile("s_waitcnt lgkmcnt(0)":::"memory");
    #pragma unroll
    for(int d_=0;d_<4;++d_)
      #pragma unroll
      for(int r=0;r<16;++r)o[d_][r]*=wsf[crow(r,hi)];
    const u32x4 pw0=(u32x4){cvtpk_s(p0[0],p0[1]),cvtpk_s(p0[2],p0[3]),cvtpk_s(p0[4],p0[5]),cvtpk_s(p0[6],p0[7])},pw1=(u32x4){cvtpk_s(p0[8],p0[9]),cvtpk_s(p0[10],p0[11]),cvtpk_s(p0[12],p0[13]),cvtpk_s(p0[14],p0[15])};
    const u32x4 pw2=(u32x4){cvtpk_s(p1[0],p1[1]),cvtpk_s(p1[2],p1[3]),cvtpk_s(p1[4],p1[5]),cvtpk_s(p1[6],p1[7])},pw3=(u32x4){cvtpk_s(p1[8],p1[9]),cvtpk_s(p1[10],p1[11]),cvtpk_s(p1[12],p1[13]),cvtpk_s(p1[14],p1[15])};
    asm volatile("s_waitcnt vmcnt(8)":::"memory");
    SBAR(); pv(o,vb,__builtin_bit_cast(bf16x8,pw0),__builtin_bit_cast(bf16x8,pw1),__builtin_bit_cast(bf16x8,pw2),__builtin_bit_cast(bf16x8,pw3));
    #pragma unroll
    for(int i=0;i<8;++i)kf[i]=kn[i];
  }
  asm volatile("s_waitcnt vmcnt(0)":::"memory");
  {auto rr=__builtin_amdgcn_permlane32_swap(__float_as_uint(l),__float_as_uint(l),false,false);l=__uint_as_float(rr[0])+__uint_as_float(rr[1]);}
  if(hi==0){ML[wid*64+r32]=m;ML[wid*64+32+r32]=l;}
  { float*const OPw=(float*)(shm+wid*16384);
    #pragma unroll
    for(int d_=0;d_<4;++d_)
      #pragma unroll
      for(int r=0;r<16;++r)OPw[(d_*16+r)*64+lane]=o[d_][r]; }
  asm volatile("s_waitcnt lgkmcnt(0)\n\ts_barrier":::"memory");
  if(wid<4){
    float mw[8],lw[8]; float M=-INFINITY;
    #pragma unroll
    for(int w=0;w<8;++w){mw[w]=ML[w*64+r32];lw[w]=ML[w*64+32+r32];M=__builtin_fmaxf(M,mw[w]);}
    float L=0.f;
    #pragma unroll
    for(int w=0;w<8;++w){mw[w]=__builtin_amdgcn_exp2f(mw[w]-M);L+=lw[w]*mw[w];}
    const float rl=__builtin_amdgcn_rcpf(L);
    if(hi==0){
      #pragma unroll
      for(int w=0;w<8;++w)SC[w*32+r32]=mw[w]*rl; }
    asm volatile("s_waitcnt lgkmcnt(0)":::"memory");
    float acc[8];
    #pragma unroll
    for(int r=0;r<8;++r)acc[r]=0.f;
    #pragma unroll
    for(int w=0;w<8;++w){ const float*const OPw=(const float*)(shm+w*16384);
      #pragma unroll
      for(int r=0;r<8;++r)acc[r]+=OPw[(wid*16+r)*64+lane]*SC[w*32+crow(r,hi)]; }
    #pragma unroll
    for(int r=0;r<8;++r){ const int row=crow(r,hi); if(row<nvalid)O[(rowbase+q0+row)*OP+wid*32+r32]=__float2bfloat16(acc[r]); }
  }
  asm volatile("s_waitcnt lgkmcnt(0)\n\ts_barrier":::"memory");
}
constexpr int ATTN_LDS_BYTES=LDS_BYTES;
#undef SBAR
#undef WAIT_BAR
}

constexpr int NWAVES = 8, NTHREADS = NWAVES * 64;
constexpr int DM = 1024, NB = 8, SEQ = 4096, NMETA = 16, LSEQ = SEQ + NMETA;
constexpr int M = NB * LSEQ;
constexpr int MP = 33024;
constexpr int MMAIN = NB * SEQ;
constexpr int DIN = 3072, DCONV = 512, NHEADS = 4, FF0 = 2816, NEXP = 8, FFE = 3584;
constexpr float LN_EPS = 1e-5f, RMS_EPS = 1e-5f;
constexpr float ALPHA = 1.41421356237309515f;
constexpr int MOE_CAPT = 128, MOE_CAPR = MOE_CAPT * 256;
constexpr int MOE_MAXT = 264;
constexpr int MOE_CH = MOE_MAXT, MOE_NCH = 1;
constexpr int MOE_NA1 = 146;
constexpr int NPHASES = 18;
#ifndef ATTN_THRL
#define ATTN_THRL 8
#endif
#ifndef MOE_SP2
#define MOE_SP2 true
#endif
#ifndef MOE_ALIGN
#define MOE_ALIGN true
#endif
constexpr float OS_SC = 16.f;
constexpr float WS_GU = 32.f, WS_DN = 128.f;

constexpr size_t MiB = 1u << 20;
constexpr size_t WS_CTL = 0, CTL_ZERO_BYTES = 256 * 1024;
constexpr size_t WS_ROPE_C = 1 * MiB, WS_ROPE_S = 2 * MiB;
constexpr size_t WS_TOKINFO = 3 * MiB;
constexpr size_t WS_ROWINFO = 164 * MiB;
constexpr size_t WS_STATS = 256 * 1024;
constexpr size_t STATS_BYTES = (size_t)2 * MP * 8;
constexpr size_t CV_OFF = 64 * 1024;
constexpr int CV_C1GU = 0, CV_C0GU = 2 * FF0, CV_C1IN = 4 * FF0, CV_C0IN = 4 * FF0 + DIN, CV_WORDS = 4 * FF0 + 2 * DIN;
constexpr size_t WS_WMOE_GU = 6 * MiB;
constexpr size_t WS_WMOE_D = 62 * MiB;
constexpr size_t WS_H8 = 90 * MiB;
constexpr size_t WS_WGU0_8 = 122 * MiB;
constexpr size_t WS_WD0_8 = 128 * MiB;
constexpr size_t WS_X8 = 131 * MiB;
constexpr size_t WS_H = 174 * MiB;
constexpr size_t WS_WIN = 239 * MiB;
constexpr size_t WS_WOUT = 251 * MiB;
constexpr size_t WS_WGU0 = 255 * MiB;
constexpr size_t WS_WD0 = 266 * MiB;
constexpr size_t WS_S = 272 * MiB;
constexpr size_t WS_Q = WS_S, WS_K = WS_S + 33 * MiB, WS_V = WS_S + 66 * MiB, WS_UC = WS_S + 99 * MiB, WS_UH = WS_S + 132 * MiB, WS_CAT = WS_S + 165 * MiB;
constexpr size_t WS_PRE = WS_S;
constexpr size_t WS_ACT0 = WS_S, WS_PRE2 = WS_S + 178 * MiB;
constexpr size_t WS_ASORT = 239 * MiB, WS_OUTSLOT = 371 * MiB;
constexpr size_t WS_ACT2 = WS_ASORT;
constexpr size_t WS_PART = 90 * MiB;
static_assert(WS_PART + (size_t)32 * 7 * 65536 * 4 <= WS_ROWINFO && WS_ACT2 + (size_t)(MOE_MAXT - MOE_NA1) * 256 * FFE <= WS_OUTSLOT, "map");
constexpr size_t WS_END = 529 * MiB;
constexpr size_t DO_UB = 0, DO_OV = 33 * MiB, DO_ACT = 0;
static_assert(WS_X8 + (size_t)32768 * DM <= WS_ROWINFO && WS_ROWINFO + (size_t)NEXP * MOE_CAPR * 8 <= WS_H && pg8::PG8_GI_OFF == 132096, "map");
static_assert(WS_H8 + (size_t)MMAIN * DM <= WS_WGU0_8 && WS_WGU0_8 + (size_t)2 * FF0 * DM <= WS_WD0_8 && WS_WD0_8 + (size_t)DM * FF0 <= WS_X8 && WS_X8 + (size_t)32768 * DM <= WS_H, "map");
static_assert(WS_H + (size_t)MP * DM * 2 <= WS_WIN && WS_WD0 + (size_t)DM * FF0 * 2 <= WS_S, "map");
static_assert(WS_CAT + (size_t)MP * DM * 2 <= WS_END && WS_PRE2 + (size_t)MP * DM * 2 <= WS_END && WS_ACT0 + (size_t)MP * FF0 * 2 <= WS_PRE2, "map");
static_assert(WS_WMOE_D + (size_t)NEXP * DM * FFE <= WS_H8 && WS_H8 + (size_t)MMAIN * DM <= WS_H && WS_ASORT + (size_t)MOE_MAXT * 256 * DM <= WS_OUTSLOT && WS_OUTSLOT + (size_t)2 * MMAIN * DM * 2 <= WS_END, "map");
static_assert(DO_OV + (size_t)MP * DM * 2 <= (size_t)MMAIN * DM * 4 && (size_t)MOE_NA1 * 256 * FFE <= (size_t)MMAIN * DM * 4, "d_out scratch");
constexpr int CW_TMO = 0, CW_CODE = 1, CW_BAR = 4096, CW_QCTR = 8192, CW_CNT = 8448;
static_assert((CW_CNT + 64 * 8) * 4 <= (int)CV_OFF && CV_OFF + (size_t)CV_WORDS * 4 <= CTL_ZERO_BYTES && CTL_ZERO_BYTES + STATS_BYTES <= MiB && WS_STATS == CTL_ZERO_BYTES, "ctl");

constexpr int RING_OFF = 0, RING_BYTES = 131072;
constexpr int LDSCTL_OFF = RING_BYTES, MISC_OFF = LDSCTL_OFF + 320;
constexpr int LDS_BYTES = 147456;

#define GAS __attribute__((address_space(1)))
#define LAS __attribute__((address_space(3)))
typedef unsigned short bf16;
typedef unsigned v4u __attribute__((ext_vector_type(4)));
typedef unsigned v2u __attribute__((ext_vector_type(2)));
typedef float f32x4 __attribute__((ext_vector_type(4)));
typedef GAS unsigned gu32;
#define RLX_AGENT __ATOMIC_RELAXED, __HIP_MEMORY_SCOPE_AGENT
#define LDS_WAIT() asm volatile("s_waitcnt lgkmcnt(0)" ::: "memory")
#define VM_WAIT() asm volatile("s_waitcnt vmcnt(0)" ::: "memory")
__device__ __forceinline__ unsigned f2bf(float f) { unsigned u = __builtin_bit_cast(unsigned, f); return (u + 0x7fffu + ((u >> 16) & 1u)) >> 16; }
typedef float f32x2p __attribute__((ext_vector_type(2))); typedef __bf16 bf16x2p __attribute__((ext_vector_type(2)));
__device__ __forceinline__ unsigned pk2(float lo, float hi) { const f32x2p v = {lo, hi}; const bf16x2p b = __builtin_convertvector(v, bf16x2p); return __builtin_bit_cast(unsigned, b); }
__device__ __forceinline__ unsigned pk4_fp8(float a, float b, float c, float d) { unsigned w = 0; w = (unsigned)__builtin_amdgcn_cvt_pk_fp8_f32(a, b, (int)w, false); w = (unsigned)__builtin_amdgcn_cvt_pk_fp8_f32(c, d, (int)w, true); return w; }
__device__ __forceinline__ float bflo(unsigned w) { return __builtin_bit_cast(float, w << 16); }
__device__ __forceinline__ float bfhi(unsigned w) { return __builtin_bit_cast(float, w & 0xffff0000u); }

#define XB_TMO      128
#define XB_XCNT(j)  (256  + 64 * (j))
#define XB_XSUB(j)  (1280 + 64 * (j))
#define XB_XGEN(j)  (2304 + 64 * (j))
#define XB_TOP      3328
#define XB_TOPGEN   3392
#define XCD_BAR_WORDS 3456
#define XB_SPIN_CAP (1u << 18)

__device__ __forceinline__ unsigned xb_ld(unsigned* p)              { return __hip_atomic_load(p, __ATOMIC_RELAXED, __HIP_MEMORY_SCOPE_AGENT); }
__device__ __forceinline__ unsigned xb_add(unsigned* p, unsigned v) { return __hip_atomic_fetch_add(p, v, __ATOMIC_RELAXED, __HIP_MEMORY_SCOPE_AGENT); }
__device__ __forceinline__ unsigned xb_xcc_id() { return (unsigned)__builtin_amdgcn_s_getreg((3 << 11) | 20) & 0xFu; }
#define XB_SPIN(cond, bar) do { unsigned _sp = 0; while (cond) { __builtin_amdgcn_s_sleep(1); \
    if ((++_sp & 255u) == 0u) { if (xb_ld(&(bar)[XB_TMO])) break; if (_sp > XB_SPIN_CAP) { atomicAdd(&(bar)[XB_TMO], 1u); break; } } } } while (0)

struct XcdBarrier {
    unsigned* bar; unsigned x;
    volatile LAS unsigned* st;
};

__device__ __forceinline__ XcdBarrier xcd_barrier_post(unsigned* bar, volatile LAS unsigned* st) {
    XcdBarrier b; b.bar = bar; b.x = xb_xcc_id(); b.st = st;
    if (threadIdx.x == 0) (void)xb_add(&bar[XB_XCNT(b.x)], 1u);
    return b;
}
__device__ __forceinline__ void xcd_barrier_complete(unsigned* bar, unsigned x, unsigned& nloc, unsigned& nx) {
    const unsigned G = gridDim.x * gridDim.y * gridDim.z;
    unsigned sum, cnt, mine, sp = 0u;
    for (;;) {
        sum = 0u; cnt = 0u; mine = 0u;
#pragma unroll
        for (unsigned j = 0; j < 16; ++j) { const unsigned c = xb_ld(&bar[XB_XCNT(j)]); sum += c; cnt += (c > 0u) ? 1u : 0u; mine = (j == x) ? c : mine; }
        if (sum == G) break;
        __builtin_amdgcn_s_sleep(1);
        if ((++sp & 255u) == 0u) { if (xb_ld(&bar[XB_TMO])) break; if (sp > XB_SPIN_CAP) { atomicAdd(&bar[XB_TMO], 1u); break; } }
    }
    nloc = mine > 0u ? mine : 1u; nx = cnt > 0u ? cnt : 1u;
}

__device__ __forceinline__ void xcd_barrier(const XcdBarrier& b) {
    asm volatile("s_waitcnt vmcnt(0)" ::: "memory");
    __syncthreads();
    if (threadIdx.x == 0) {
        unsigned* bar = b.bar;
        __builtin_amdgcn_s_waitcnt(0);
        unsigned nloc = b.st[0], nx = b.st[1];
        if (nloc == 0u) { xcd_barrier_complete(bar, b.x, nloc, nx); b.st[0] = nloc; b.st[1] = nx; }
        const unsigned old = xb_add(&bar[XB_XSUB(b.x)], 1u);
        const unsigned gen = old / nloc;
        if (old + 1u == (gen + 1u) * nloc) {
            __builtin_amdgcn_fence(__ATOMIC_RELEASE, "agent");
            asm volatile("s_waitcnt vmcnt(0)" ::: "memory");
            const unsigned og = xb_add(&bar[XB_TOP], 1u);
            const unsigned tg = og / nx;
            if (og + 1u == (tg + 1u) * nx) xb_add(&bar[XB_TOPGEN], 1u);
            else XB_SPIN(xb_ld(&bar[XB_TOPGEN]) == tg, bar);
            __builtin_amdgcn_fence(__ATOMIC_ACQUIRE, "agent");
            xb_add(&bar[XB_XGEN(b.x)], 1u);
            asm volatile("s_waitcnt vmcnt(0)" ::: "memory");
        } else {
            XB_SPIN(xb_ld(&bar[XB_XGEN(b.x)]) == gen, bar);
            __builtin_amdgcn_fence(__ATOMIC_ACQUIRE, "agent");
            asm volatile("s_waitcnt vmcnt(0)" ::: "memory");
        }
    }
    __syncthreads();
}

#ifndef MK_PER_PHASE
#define MK_PER_PHASE 0
#endif
struct Args { const float* in[23]; float* out; unsigned char* ws; int ph_lo, ph_hi; };
typedef const __attribute__((address_space(4))) Args* KArgs;
__device__ __forceinline__ KArgs kargs() { KArgs p = (KArgs)__builtin_amdgcn_kernarg_segment_ptr(); asm volatile("" : "+s"(p)); return p; }
#define AIN(i) ((const float*)kargs()->in[i])
#define WSB() ((unsigned char*)kargs()->ws)
#define DOB() ((unsigned char*)kargs()->out)
#define MOE_TE(k) (((const volatile LAS int*)(lds_base + MISC_OFF))[32 + (k)])

namespace pg8 {
constexpr float C2 = 0.125f * 1.4426950408889634f;
__device__ __forceinline__ void ln_stats(const int* st, int r, float& mu, float& rs) {
    const v2u w = *(const v2u*)(st + 2 * r); const int sx = (int)w.x, qx = (int)w.y;
    mu = (float)sx * (1.0f / (65536.0f * 1024.0f)); const float ex2 = (float)qx * (1.0f / (4096.0f * 1024.0f));
    rs = __builtin_amdgcn_rsqf(ex2 - mu * mu + LN_EPS);
}
__device__ __forceinline__ f32x4 cv4(const int* c, int i) { typedef int i32x4v __attribute__((ext_vector_type(4))); const i32x4v v = *(const i32x4v*)(c + i); return (f32x4){(float)v[0], (float)v[1], (float)v[2], (float)v[3]} * (1.0f / 1048576.0f); }
constexpr int FIX_LDS_OFF = 132096;
template <int WHICH> __device__ __forceinline__ void ln_fix_prefetch(PG8_LAS unsigned char* ring, const Unit& u, int wid, int lane) {
    if (wid < 4) {
        unsigned char* const ws = WSB(); const int* const st = (const int*)(ws + WS_STATS) + (WHICH == 1 ? 0 : 2 * MP);
        const int* const cb = (const int*)(ws + WS_CTL + CV_OFF);
        const int* src = wid == 0 ? cb + (WHICH == 1 ? CV_C1GU : CV_C1IN) + u.pn * BM : wid == 1 ? cb + (WHICH == 1 ? CV_C0GU : CV_C0IN) + u.pn * BM : st + 2 * (u.pm * BM + (wid - 2) * 128);
        __builtin_amdgcn_global_load_lds((const unsigned*)(src + 4 * lane), (PG8_LAS unsigned*)(ring + FIX_LDS_OFF + wid * 1024), 16, 0, 0);
    }
}
__device__ __forceinline__ void ln_stats_lds(const PG8_LAS int* st, int rl, float& mu, float& rs) {
    typedef int i32x2v __attribute__((ext_vector_type(2))); const i32x2v w = *(const PG8_LAS i32x2v*)(st + 2 * rl); const int sx = w.x, qx = w.y;
    mu = (float)sx * (1.0f / (65536.0f * 1024.0f)); const float ex2 = (float)qx * (1.0f / (4096.0f * 1024.0f)); rs = __builtin_amdgcn_rsqf(ex2 - mu * mu + LN_EPS);
}
template <int WHICH> __device__ __forceinline__ f32x4 cv4_lds(const PG8_LAS int* c, int i) { typedef int i32x4v __attribute__((ext_vector_type(4))); const i32x4v v = *(const PG8_LAS i32x4v*)(c + i);
    return (f32x4){(float)v[0], (float)v[1], (float)v[2], (float)v[3]} * ((WHICH == 1 ? WS_GU : 1.0f) / 1048576.0f); }
template <int WHICH> __device__ __forceinline__ void ln_fix_tile(f32x4 (&acc)[2][2][4][2], PG8_LAS unsigned char* ring, int wr, int wc, int fr, int fq) {
    const PG8_LAS int* const c1 = (const PG8_LAS int*)(ring + FIX_LDS_OFF); const PG8_LAS int* const c0 = c1 + 256; const PG8_LAS int* const st = c1 + 512;
    const int row0 = wr * 64 + fr, colg = wc * 32 + 8 * fq;
    float mu[2][4], rs[2][4];
#pragma unroll
    for (int ai = 0; ai < 2; ++ai)
#pragma unroll
        for (int m = 0; m < 4; ++m) ln_stats_lds(st, row0 + ai * HALF + m * 16, mu[ai][m], rs[ai][m]);
#pragma unroll
    for (int bj = 0; bj < 2; ++bj)
#pragma unroll
        for (int n = 0; n < 2; ++n) { const f32x4 k1 = cv4_lds<WHICH>(c1, colg + bj * HALF + 4 * n), k0 = cv4_lds<WHICH>(c0, colg + bj * HALF + 4 * n);
#pragma unroll
            for (int ai = 0; ai < 2; ++ai)
#pragma unroll
                for (int m = 0; m < 4; ++m) acc[ai][bj][m][n] = (acc[ai][bj][m][n] - k1 * mu[ai][m]) * rs[ai][m] + k0; }
}
template <bool L1> struct EpiInProj {
    static constexpr bool PERM = true, AFTER_DRAIN = false, HASFIX = L1;
    PG8_LAS unsigned char* ring;
    __device__ __forceinline__ void prefetch(const Unit& u, int wid, int lane) const { ln_fix_prefetch<2>(ring, u, wid, lane); }
    __device__ __forceinline__ void fix(f32x4 (&acc)[2][2][4][2], const Unit& u, int wr, int wc, int fr, int fq) const { ln_fix_tile<2>(acc, ring, wr, wc, fr, fq); }
    __device__ __forceinline__ void operator()(const f32x4 (&acc)[2][2][4][2], const Unit& u, int wr, int wc, int fr, int fq) const {
        const int kind = u.pn >> 1, colt = (u.pn & 1) * 256, row0 = u.pm * BM + wr * 64 + fr;
        unsigned char* const ws = WSB();
        bf16_t* base = kind == 0 ? (bf16_t*)(DOB() + DO_UB) : (bf16_t*)(ws + (kind == 1 ? WS_UC : kind == 2 ? WS_UH : kind == 3 ? WS_Q : kind == 4 ? WS_K : WS_V));
        const float* const cs = (const float*)(ws + WS_ROPE_C); const float* const sn = (const float*)(ws + WS_ROPE_S);
        if (kind == 3 || kind == 4) {
            const float sc = kind == 3 ? C2 : 1.0f; const int d0 = 16 * (wc & 1) + 4 * fq;
            f32x4 cc[2][4], ss[2][4];
#pragma unroll
            for (int ai = 0; ai < 2; ++ai)
#pragma unroll
                for (int m = 0; m < 4; ++m) { const int r = row0 + ai * HALF + m * 16; const int t = r % 4112; cc[ai][m] = *(const f32x4*)(cs + t * 32 + d0); ss[ai][m] = *(const f32x4*)(sn + t * 32 + d0); }
#pragma unroll
            for (int ai = 0; ai < 2; ++ai)
#pragma unroll
                for (int m = 0; m < 4; ++m) { const int r = row0 + ai * HALF + m * 16; const f32x4 c4 = cc[ai][m], s4 = ss[ai][m];
#pragma unroll
                    for (int bj = 0; bj < 2; ++bj) { const int G = 2 * bj + (wc >> 1); const f32x4 lo = acc[ai][bj][m][0], hi = acc[ai][bj][m][1];
                        const f32x4 olo = (lo * c4 - hi * s4) * sc, ohi = (hi * c4 + lo * s4) * sc;
                        bf16_t* p = base + (size_t)r * 512 + colt + 64 * G + d0;
                        typedef unsigned u32x2 __attribute__((ext_vector_type(2)));
                        u32x2 a, b; a.x = cvt_pk_bf16(olo[0], olo[1]); a.y = cvt_pk_bf16(olo[2], olo[3]); b.x = cvt_pk_bf16(ohi[0], ohi[1]); b.y = cvt_pk_bf16(ohi[2], ohi[3]);
                        *(u32x2*)p = a; *(u32x2*)(p + 32) = b; } }
        } else {
            const int col0 = colt + wc * 32 + 8 * fq;
#pragma unroll
            for (int ai = 0; ai < 2; ++ai)
#pragma unroll
                for (int m = 0; m < 4; ++m) { bf16_t* rowp = base + (size_t)(row0 + ai * HALF + m * 16) * 512 + col0;
#pragma unroll
                    for (int bj = 0; bj < 2; ++bj) { const f32x4 v0 = acc[ai][bj][m][0], v1 = acc[ai][bj][m][1];
                        u32x4 w; w.x = cvt_pk_bf16(v0[0], v0[1]); w.y = cvt_pk_bf16(v0[2], v0[3]); w.z = cvt_pk_bf16(v1[0], v1[1]); w.w = cvt_pk_bf16(v1[2], v1[3]);
                        *(u32x4*)(rowp + bj * HALF) = w; } }
        }
    }
};
__device__ __forceinline__ float silu_mul(float g, float u) { return g * __builtin_amdgcn_rcpf(1.0f + __builtin_amdgcn_exp2f(-1.4426950408889634f * g)) * u; }
typedef float f32x2 __attribute__((ext_vector_type(2)));
template <bool SCALED> __device__ __forceinline__ f32x2 silu_mul2(f32x2 g, f32x2 u, float c1, float s2) {
    const f32x2 a = g * c1; f32x2 e; e.x = __builtin_amdgcn_exp2f(a.x); e.y = __builtin_amdgcn_exp2f(a.y);
    const f32x2 d = e + 1.0f; f32x2 r; r.x = __builtin_amdgcn_rcpf(d.x); r.y = __builtin_amdgcn_rcpf(d.y);
    f32x2 t = (g * u) * r; if (SCALED) t = t * s2; return t;
}
struct EpiSwiGLU {
    static constexpr bool PERM = true, AFTER_DRAIN = false, HASFIX = true;
    PG8_LAS unsigned char* ring;
    __device__ __forceinline__ void prefetch(const Unit& u, int wid, int lane) const { ln_fix_prefetch<1>(ring, u, wid, lane); }
    __device__ __forceinline__ void fix(f32x4 (&acc)[2][2][4][2], const Unit& u, int wr, int wc, int fr, int fq) const { ln_fix_tile<1>(acc, ring, wr, wc, fr, fq); }
    __device__ __forceinline__ void operator()(const f32x4 (&acc)[2][2][4][2], const Unit& u, int wr, int wc, int fr, int fq) const {
        unsigned char* const O = WSB() + WS_ACT0; constexpr float s = 1.0f / WS_GU;
        const int row0 = u.pm * BM + wr * 64 + fr, col0 = u.pn * 128 + wc * 32 + 8 * fq;
#pragma unroll
        for (int ai = 0; ai < 2; ++ai)
#pragma unroll
            for (int m = 0; m < 4; ++m) { unsigned char* rowp = O + (size_t)(row0 + ai * HALF + m * 16) * FF0 + col0;
                const f32x4 g0 = acc[ai][0][m][0], g1 = acc[ai][0][m][1], u0 = acc[ai][1][m][0], u1 = acc[ai][1][m][1];
                constexpr float C1 = -1.4426950408889634f * s, S2 = s * s;
                const f32x2 a0 = silu_mul2<true>((f32x2){g0[0], g0[1]}, (f32x2){u0[0], u0[1]}, C1, S2), a1 = silu_mul2<true>((f32x2){g0[2], g0[3]}, (f32x2){u0[2], u0[3]}, C1, S2);
                const f32x2 a2 = silu_mul2<true>((f32x2){g1[0], g1[1]}, (f32x2){u1[0], u1[1]}, C1, S2), a3 = silu_mul2<true>((f32x2){g1[2], g1[3]}, (f32x2){u1[2], u1[3]}, C1, S2);
                typedef unsigned u32x2 __attribute__((ext_vector_type(2)));
                u32x2 w; w.x = pk4_fp8(a0.x, a0.y, a1.x, a1.y); w.y = pk4_fp8(a2.x, a2.y, a3.x, a3.y);
                *(u32x2*)rowp = w; }
    }
};
struct EpiSwiGLU8 {
    static constexpr bool PERM = true, AFTER_DRAIN = false, HASFIX = false;
    LAS unsigned char* lds_base; int t0;
    __device__ __forceinline__ void operator()(const f32x4 (&acc)[2][2][4][2], const Unit& u, int wr, int wc, int fr, int fq) const {
        constexpr int npn = FFE / 128; constexpr float s = 1.0f / WS_GU;
        const int tg = u.pm; int e = 0;
#pragma unroll
        for (int k = 0; k < 7; ++k) e += (tg >= MOE_TE(k)) ? 1 : 0;
        const int pc = u.pn - e * npn, prow0 = u.pm - t0;
        unsigned char* const O = prow0 < MOE_NA1 ? DOB() + DO_ACT : WSB() + WS_ACT2; const int prow = prow0 < MOE_NA1 ? prow0 : prow0 - MOE_NA1;
        const int row0 = prow * BM + wr * 64 + fr, col0 = pc * 128 + wc * 32 + 8 * fq;
#pragma unroll
        for (int ai = 0; ai < 2; ++ai)
#pragma unroll
            for (int m = 0; m < 4; ++m) { unsigned char* rowp = O + (size_t)(row0 + ai * HALF + m * 16) * FFE + col0;
                const f32x4 g0 = acc[ai][0][m][0], g1 = acc[ai][0][m][1], u0 = acc[ai][1][m][0], u1 = acc[ai][1][m][1];
                constexpr float C1 = -1.4426950408889634f * s, S2 = s * s;
                const f32x2 a0 = silu_mul2<true>((f32x2){g0[0], g0[1]}, (f32x2){u0[0], u0[1]}, C1, S2), a1 = silu_mul2<true>((f32x2){g0[2], g0[3]}, (f32x2){u0[2], u0[3]}, C1, S2);
                const f32x2 a2 = silu_mul2<true>((f32x2){g1[0], g1[1]}, (f32x2){u1[0], u1[1]}, C1, S2), a3 = silu_mul2<true>((f32x2){g1[2], g1[3]}, (f32x2){u1[2], u1[3]}, C1, S2);
                typedef unsigned u32x2 __attribute__((ext_vector_type(2)));
                u32x2 w; w.x = pk4_fp8(a0.x, a0.y, a1.x, a1.y); w.y = pk4_fp8(a2.x, a2.y, a3.x, a3.y);
                *(u32x2*)rowp = w; }
    }
};
template <int MODE, bool ACC8> __device__ __forceinline__ void resid8(const u32x4 h, const f32x4 v0, const f32x4 v1, float mu, float rs, const f32x4 (&gg)[2], const f32x4 (&bb)[2], float& s, float& q, u32x4& w, v2u& w8) {
    float x[8] = {__builtin_bit_cast(float, h.x << 16), __builtin_bit_cast(float, h.x & 0xffff0000u), __builtin_bit_cast(float, h.y << 16), __builtin_bit_cast(float, h.y & 0xffff0000u),
                  __builtin_bit_cast(float, h.z << 16), __builtin_bit_cast(float, h.z & 0xffff0000u), __builtin_bit_cast(float, h.w << 16), __builtin_bit_cast(float, h.w & 0xffff0000u)};
#pragma unroll
    for (int i = 0; i < 8; ++i) { float hv = x[i]; if (MODE != 0) hv = (hv - mu) * rs * gg[i >> 2][i & 3] + bb[i >> 2][i & 3];
        x[i] = ALPHA * hv + (i < 4 ? v0[i & 3] : v1[i & 3]) * (ACC8 ? 1.0f / WS_DN : 1.0f); s += x[i]; q += x[i] * x[i]; }
    w.x = cvt_pk_bf16(x[0], x[1]); w.y = cvt_pk_bf16(x[2], x[3]); w.z = cvt_pk_bf16(x[4], x[5]); w.w = cvt_pk_bf16(x[6], x[7]);
    if (MODE == 0) { w8.x = pk4_fp8(x[0], x[1], x[2], x[3]); w8.y = pk4_fp8(x[4], x[5], x[6], x[7]); }
}
template <int MODE> struct EpiResid {
    static constexpr bool PERM = true, AFTER_DRAIN = false, HASFIX = false;
    int dummy;
    __device__ __forceinline__ void operator()(const f32x4 (&acc)[2][2][4][2], const Unit& u, int wr, int wc, int fr, int fq) const {
        const int row0 = u.pm * BM + wr * 64 + fr, col0 = u.pn * BM + wc * 32 + 8 * fq;
        unsigned char* const ws = WSB(); bf16_t* const X = (bf16_t*)(ws + WS_H); bf16_t* const P = MODE == 2 ? (bf16_t*)(ws + WS_PRE) : X;
        int* const sti = (int*)(ws + WS_STATS) + (MODE == 1 ? 0 : 2 * MP);
        int* const sto = (int*)(ws + WS_STATS) + (MODE == 0 ? 0 : 2 * MP);
        const float* const lg = kargs()->in[MODE == 1 ? 12 : 14]; const float* const lb = kargs()->in[MODE == 1 ? 13 : 15];
        f32x4 gg[2][2], bb[2][2];
        if (MODE != 0) {
#pragma unroll
            for (int bj = 0; bj < 2; ++bj)
#pragma unroll
                for (int n = 0; n < 2; ++n) { gg[bj][n] = *(const f32x4*)(lg + col0 + bj * HALF + 4 * n); bb[bj][n] = *(const f32x4*)(lb + col0 + bj * HALF + 4 * n); }
        }
#pragma unroll
        for (int ai = 0; ai < 2; ++ai) {
            u32x4 hh[4][2]; float mu[4], rs[4];
#pragma unroll
            for (int m = 0; m < 4; ++m) { const int r = row0 + ai * HALF + m * 16; const size_t off = (size_t)r * 1024 + col0;
                hh[m][0] = *(const u32x4*)(X + off); hh[m][1] = *(const u32x4*)(X + off + HALF);
                if (MODE != 0) ln_stats(sti, r, mu[m], rs[m]); else { mu[m] = 0.f; rs[m] = 1.f; } }
#pragma unroll
            for (int m = 0; m < 4; ++m) { const int r = row0 + ai * HALF + m * 16; const size_t off = (size_t)r * 1024 + col0;
                float s = 0.f, q = 0.f; u32x4 w0, w1; v2u e0, e1;
                resid8<MODE, MODE == 1>(hh[m][0], acc[ai][0][m][0], acc[ai][0][m][1], mu[m], rs[m], gg[0], bb[0], s, q, w0, e0);
                resid8<MODE, MODE == 1>(hh[m][1], acc[ai][1][m][0], acc[ai][1][m][1], mu[m], rs[m], gg[1], bb[1], s, q, w1, e1);
                *(u32x4*)(P + off) = w0; *(u32x4*)(P + off + HALF) = w1;
                if (MODE == 0) { unsigned char* const X8 = ws + WS_X8; *(v2u*)(X8 + off) = e0; *(v2u*)(X8 + off + HALF) = e1; }
                if (MODE != 2) { s += __shfl_xor(s, 16); s += __shfl_xor(s, 32); q += __shfl_xor(q, 16); q += __shfl_xor(q, 32);
                    if (fq < 2) __hip_atomic_fetch_add(sto + 2 * r + fq, fq == 0 ? __float2int_rn(s * 65536.0f) : __float2int_rn(q * 4096.0f), __ATOMIC_RELAXED, __HIP_MEMORY_SCOPE_AGENT); } }
        }
    }
};
struct EpiMoeDown {
    static constexpr bool PERM = true, AFTER_DRAIN = false, HASFIX = false;
    LAS unsigned char* lds_base; int t0;
    __device__ __forceinline__ void operator()(const f32x4 (&acc)[2][2][4][2], const Unit& u, int wr, int wc, int fr, int fq) const {
        constexpr int npn = DM / 256, mmain = MMAIN; unsigned char* const ws = WSB(); const int* const rowinfo = (const int*)(ws + WS_ROWINFO); bf16_t* const OS = (bf16_t*)(ws + WS_OUTSLOT);
        const int tg = t0 + u.pm; int e = 0;
#pragma unroll
        for (int k = 0; k < 7; ++k) e += (tg >= MOE_TE(k)) ? 1 : 0;
        int pte = 0;
#pragma unroll
        for (int k = 0; k < 7; ++k) { const int tv = MOE_TE(k); if (tg >= tv) pte = tv; }
        const int pc = u.pn - e * npn; const int row0 = (e * MOE_CAPT + (tg - pte)) * BM + wr * 64 + fr, col0 = pc * BM + wc * 32 + 8 * fq;
        int tsv[2][4]; float gtv[2][4];
#pragma unroll
        for (int ai = 0; ai < 2; ++ai)
#pragma unroll
            for (int m = 0; m < 4; ++m) { const int r = row0 + ai * HALF + m * 16; const v2u ri = *(const v2u*)(rowinfo + 2 * r); const unsigned rx = ri.x, ry = ri.y;
                tsv[ai][m] = (int)rx; gtv[ai][m] = __builtin_bit_cast(float, ry) * (OS_SC / WS_DN); }
#pragma unroll
        for (int ai = 0; ai < 2; ++ai)
#pragma unroll
            for (int m = 0; m < 4; ++m) { const int ts = tsv[ai][m]; const float gt = gtv[ai][m];
                if (ts >= 0) { unsigned char* rowp = (unsigned char*)OS + ((size_t)(ts & 1) * mmain + (size_t)(ts >> 1)) * 1024 + col0;
#pragma unroll
                    for (int bj = 0; bj < 2; ++bj) { const f32x4 v0 = acc[ai][bj][m][0] * gt, v1 = acc[ai][bj][m][1] * gt;
                        v2u w; w.x = pk4_fp8(v0[0], v0[1], v0[2], v0[3]); w.y = pk4_fp8(v1[0], v1[1], v1[2], v1[3]);
                        *(v2u*)(rowp + bj * HALF) = w; } } }
    }
};
constexpr int MOE_NSL = 7;
template <bool A_GLOBAL> struct MoeOrder {
    LAS unsigned char* lds_base; int t0, ntl, npn, G, c; int i0 = 0, iend = 1 << 30, sbase = -1;
    __device__ __forceinline__ void decode(int L, int& pml, int& pc, int& e, int& pte) const {
        const int nwg = ntl * npn; int wgid = L; { const int q = nwg / NXCD, r = nwg % NXCD, xcd = wgid % NXCD, off = wgid / NXCD; wgid = (xcd < r ? xcd * (q + 1) : r * (q + 1) + (xcd - r) * q) + off; }
        const int nig = WGM * npn, gid = wgid / nig, fm = gid * WGM, gsz = (ntl - fm) < WGM ? (ntl - fm) : WGM;
        pml = fm + ((wgid % nig) % gsz); pc = (wgid % nig) / gsz; const int tg = t0 + pml; e = 0; pte = 0;
#pragma unroll
        for (int k = 0; k < 7; ++k) { const int tv = MOE_TE(k); if (tg >= tv) { e = k + 1; pte = tv; } }
    }
    __device__ __forceinline__ bool next_lane(int i, Unit& u) const {
        const int nwg = ntl * npn; long L; int slice = 0, slot = 0;
        if (sbase >= 0) { const long j = (long)i * G + c; L = sbase + j / MOE_NSL; slice = (int)(j % MOE_NSL); slot = (int)j; }
        else { if (i + i0 >= iend) return false; L = (long)(i + i0) * G + c; }
        if (L >= nwg) return false;
        int pml, pc, e, pte; decode((int)L, pml, pc, e, pte); const int tg = t0 + pml;
        u.pm = A_GLOBAL ? tg : pml; u.pn = e * npn + pc; u.pv = sbase >= 0 ? slice : e * MOE_CAPT + (tg - pte); u.pq = slot; return true;
    }
    __device__ __forceinline__ void a_ready(const Unit&) const {}
    __device__ __forceinline__ void done(const Unit&) const {}
};
struct EpiPartial {
    static constexpr bool PERM = true, AFTER_DRAIN = false, HASFIX = false;
    float* part;
    __device__ __forceinline__ void operator()(const f32x4 (&acc)[2][2][4][2], const Unit& u, int wr, int wc, int fr, int fq) const {
        float* const base = part + (size_t)u.pq * 65536 + 4 * (((wr * 4 + wc) * 64) + fq * 16 + fr);
#pragma unroll
        for (int ai = 0; ai < 2; ++ai)
#pragma unroll
            for (int bj = 0; bj < 2; ++bj)
#pragma unroll
                for (int m = 0; m < 4; ++m)
#pragma unroll
                    for (int n = 0; n < 2; ++n) *(f32x4*)(base + ((((ai * 2 + bj) * 4 + m) * 2 + n) * 2048)) = acc[ai][bj][m][n];
    }
};
}


constexpr int TAIL_R0 = 32768, MMAIN_ROWS = 32768;
template <class TEpi> __device__ __forceinline__ void tail_gemm(const bf16* A, const bf16* Bt, const int K, const int ntn, const int vcu, const int G, const int lane, const int wave, LAS unsigned char* lds, const TEpi& E) {
    typedef short bf16x8 __attribute__((ext_vector_type(8)));
    const int fr = lane & 15, fq = lane >> 4, ntasks = 32 * ntn, kc = K >> 3;
    LAS f32x4* const P = (LAS f32x4*)lds;
    for (int task = vcu; task < ntasks; task += G) {
        const int rg = task & 7, wc = (task >> 3) & 3, pn = task >> 5, row = TAIL_R0 + 16 * rg + fr;
        const GAS bf16* ap = (const GAS bf16*)A + (size_t)row * K + wave * kc + 8 * fq;
        const GAS bf16* bp = (const GAS bf16*)Bt + (size_t)(256 * pn + 32 * wc + 8 * (fr >> 2) + (fr & 3)) * K + wave * kc + 8 * fq;
        const size_t o4 = (size_t)4 * K, o128 = (size_t)128 * K;
        const typename TEpi::Pre pre = E.pre(row, pn, wc, fq);
        f32x4 acc[2][2];
#pragma unroll
        for (int i = 0; i < 2; ++i)
#pragma unroll
            for (int j = 0; j < 2; ++j) acc[i][j] = (f32x4){0.f, 0.f, 0.f, 0.f};
#pragma unroll 4
        for (int k = 0; k < kc; k += 32) {
            const bf16x8 a = *(const GAS bf16x8*)(ap + k);
            const bf16x8 b00 = *(const GAS bf16x8*)(bp + k), b01 = *(const GAS bf16x8*)(bp + o4 + k), b10 = *(const GAS bf16x8*)(bp + o128 + k), b11 = *(const GAS bf16x8*)(bp + o128 + o4 + k);
            acc[0][0] = __builtin_amdgcn_mfma_f32_16x16x32_bf16(b00, a, acc[0][0], 0, 0, 0);
            acc[0][1] = __builtin_amdgcn_mfma_f32_16x16x32_bf16(b01, a, acc[0][1], 0, 0, 0);
            acc[1][0] = __builtin_amdgcn_mfma_f32_16x16x32_bf16(b10, a, acc[1][0], 0, 0, 0);
            acc[1][1] = __builtin_amdgcn_mfma_f32_16x16x32_bf16(b11, a, acc[1][1], 0, 0, 0);
        }
#pragma unroll
        for (int i = 0; i < 2; ++i)
#pragma unroll
            for (int j = 0; j < 2; ++j) P[(wave * 4 + i * 2 + j) * 64 + lane] = acc[i][j];
        __syncthreads();
        if (wave == 0) {
#pragma unroll
            for (int i = 0; i < 2; ++i)
#pragma unroll
                for (int j = 0; j < 2; ++j) { f32x4 s = acc[i][j];
#pragma unroll
                    for (int w = 1; w < 8; ++w) s += P[(w * 4 + i * 2 + j) * 64 + lane];
                    acc[i][j] = s; }
            E(acc, row, pn, wc, fq, pre);
        }
        __syncthreads();
    }
}
typedef int i32x4t __attribute__((ext_vector_type(4)));
struct FixPre { v2u st; i32x4t c1[2][2], c0[2][2]; };
template <int WHICH> __device__ __forceinline__ FixPre fix_pre(int r, int pn, int wc, int fq) {
    unsigned char* const ws = WSB(); const int* const st = (const int*)(ws + WS_STATS) + (WHICH == 1 ? 0 : 2 * MP);
    const int* const cb = (const int*)(ws + WS_CTL + CV_OFF); const int* const c1 = cb + (WHICH == 1 ? CV_C1GU : CV_C1IN); const int* const c0 = cb + (WHICH == 1 ? CV_C0GU : CV_C0IN);
    FixPre p; p.st = *(const v2u*)(st + 2 * r); const int colg = pn * 256 + wc * 32 + 8 * fq;
#pragma unroll
    for (int bj = 0; bj < 2; ++bj)
#pragma unroll
        for (int n = 0; n < 2; ++n) { p.c1[bj][n] = *(const i32x4t*)(c1 + colg + bj * 128 + 4 * n); p.c0[bj][n] = *(const i32x4t*)(c0 + colg + bj * 128 + 4 * n); }
    return p;
}
__device__ __forceinline__ void stats_of(const v2u w, float& mu, float& rs) { const int sx = (int)w.x, qx = (int)w.y; mu = (float)sx * (1.0f / (65536.0f * 1024.0f)); const float ex2 = (float)qx * (1.0f / (4096.0f * 1024.0f)); rs = __builtin_amdgcn_rsqf(ex2 - mu * mu + LN_EPS); }
__device__ __forceinline__ f32x4 cvf(const i32x4t v) { return (f32x4){(float)v[0], (float)v[1], (float)v[2], (float)v[3]} * (1.0f / 1048576.0f); }
__device__ __forceinline__ void fix_apply(f32x4 (&acc)[2][2], const FixPre& p) {
    const v2u stw = p.st; float mu, rs; stats_of(stw, mu, rs);
#pragma unroll
    for (int bj = 0; bj < 2; ++bj)
#pragma unroll
        for (int n = 0; n < 2; ++n) { const i32x4t a = p.c1[bj][n], c = p.c0[bj][n]; acc[bj][n] = (acc[bj][n] - cvf(a) * mu) * rs + cvf(c); }
}
template <bool L1> struct TailInProj {
    int dummy;
    struct Pre { FixPre fx; f32x4 c4, s4; };
    __device__ __forceinline__ Pre pre(int r, int pn, int wc, int fq) const {
        Pre p; if (L1) p.fx = fix_pre<2>(r, pn, wc, fq);
        const int kind = pn >> 1; unsigned char* const ws = WSB();
        if (kind == 3 || kind == 4) { const float* const cs = (const float*)(ws + WS_ROPE_C); const float* const sn = (const float*)(ws + WS_ROPE_S); const int d0 = 16 * (wc & 1) + 4 * fq, t = r % 4112;
            p.c4 = *(const f32x4*)(cs + t * 32 + d0); p.s4 = *(const f32x4*)(sn + t * 32 + d0); }
        return p;
    }
    __device__ __forceinline__ void operator()(const f32x4 (&acc_)[2][2], int r, int pn, int wc, int fq, const Pre& p) const {
        f32x4 acc[2][2] = {{acc_[0][0], acc_[0][1]}, {acc_[1][0], acc_[1][1]}}; if (L1) fix_apply(acc, p.fx);
        const int kind = pn >> 1, colt = (pn & 1) * 256; unsigned char* const ws = WSB();
        bf16* base = kind == 0 ? (bf16*)(DOB() + DO_UB) : (bf16*)(ws + (kind == 1 ? WS_UC : kind == 2 ? WS_UH : kind == 3 ? WS_Q : kind == 4 ? WS_K : WS_V));
        if (kind == 3 || kind == 4) {
            const float sc = kind == 3 ? pg8::C2 : 1.0f; const int d0 = 16 * (wc & 1) + 4 * fq;
            const f32x4 c4 = p.c4, s4 = p.s4;
#pragma unroll
            for (int bj = 0; bj < 2; ++bj) { const int G = 2 * bj + (wc >> 1); const f32x4 lo = acc[bj][0], hi = acc[bj][1];
                const f32x4 olo = (lo * c4 - hi * s4) * sc, ohi = (hi * c4 + lo * s4) * sc;
                bf16* pp = base + (size_t)r * 512 + colt + 64 * G + d0;
                v2u a, b; a.x = pg8::cvt_pk_bf16(olo[0], olo[1]); a.y = pg8::cvt_pk_bf16(olo[2], olo[3]); b.x = pg8::cvt_pk_bf16(ohi[0], ohi[1]); b.y = pg8::cvt_pk_bf16(ohi[2], ohi[3]);
                *(v2u*)pp = a; *(v2u*)(pp + 32) = b; }
        } else {
            bf16* rowp = base + (size_t)r * 512 + colt + wc * 32 + 8 * fq;
#pragma unroll
            for (int bj = 0; bj < 2; ++bj) { const f32x4 v0 = acc[bj][0], v1 = acc[bj][1];
                v4u w; w.x = pg8::cvt_pk_bf16(v0[0], v0[1]); w.y = pg8::cvt_pk_bf16(v0[2], v0[3]); w.z = pg8::cvt_pk_bf16(v1[0], v1[1]); w.w = pg8::cvt_pk_bf16(v1[2], v1[3]);
                *(v4u*)(rowp + bj * 128) = w; }
        }
    }
};
template <int MODE> struct TailResid {
    int dummy;
    struct Pre { v4u h0, h1; v2u st; f32x4 gg[2][2], bb[2][2]; };
    __device__ __forceinline__ Pre pre(int r, int pn, int wc, int fq) const {
        unsigned char* const ws = WSB(); const bf16* const X = (const bf16*)(ws + WS_H);
        const int* const sti = (const int*)(ws + WS_STATS) + (MODE == 1 ? 0 : 2 * MP);
        const float* const lg = kargs()->in[MODE == 1 ? 12 : 14]; const float* const lb = kargs()->in[MODE == 1 ? 13 : 15];
        const int col0 = pn * 256 + wc * 32 + 8 * fq; const size_t off = (size_t)r * 1024 + col0;
        Pre p; p.h0 = *(const v4u*)(X + off); p.h1 = *(const v4u*)(X + off + 128);
        if (MODE != 0) { p.st = *(const v2u*)(sti + 2 * r);
#pragma unroll
            for (int bj = 0; bj < 2; ++bj)
#pragma unroll
                for (int n = 0; n < 2; ++n) { p.gg[bj][n] = *(const f32x4*)(lg + col0 + bj * 128 + 4 * n); p.bb[bj][n] = *(const f32x4*)(lb + col0 + bj * 128 + 4 * n); } }
        return p;
    }
    __device__ __forceinline__ void operator()(const f32x4 (&acc)[2][2], int r, int pn, int wc, int fq, const Pre& p) const {
        unsigned char* const ws = WSB(); bf16* const X = (bf16*)(ws + WS_H); bf16* const P = MODE == 2 ? (bf16*)(ws + WS_PRE) : X;
        int* const sto = (int*)(ws + WS_STATS) + (MODE == 0 ? 0 : 2 * MP);
        const int col0 = pn * 256 + wc * 32 + 8 * fq; const size_t off = (size_t)r * 1024 + col0;
        f32x4 gg[2][2], bb[2][2]; float mu = 0.f, rs = 1.f;
        if (MODE != 0) { const v2u stw = p.st; stats_of(stw, mu, rs);
#pragma unroll
            for (int bj = 0; bj < 2; ++bj)
#pragma unroll
                for (int n = 0; n < 2; ++n) { gg[bj][n] = p.gg[bj][n]; bb[bj][n] = p.bb[bj][n]; } }
        float s = 0.f, q = 0.f; v4u w0, w1; v2u e0, e1; const v4u h0 = p.h0, h1 = p.h1;
        pg8::resid8<MODE, false>(h0, acc[0][0], acc[0][1], mu, rs, gg[0], bb[0], s, q, w0, e0); pg8::resid8<MODE, false>(h1, acc[1][0], acc[1][1], mu, rs, gg[1], bb[1], s, q, w1, e1);
        *(v4u*)(P + off) = w0; *(v4u*)(P + off + 128) = w1;
        if (MODE != 2) { s += __shfl_xor(s, 16); s += __shfl_xor(s, 32); q += __shfl_xor(q, 16); q += __shfl_xor(q, 32);
            if (fq < 2) __hip_atomic_fetch_add(sto + 2 * r + fq, fq == 0 ? __float2int_rn(s * 65536.0f) : __float2int_rn(q * 4096.0f), __ATOMIC_RELAXED, __HIP_MEMORY_SCOPE_AGENT); }
    }
};
struct TailSwiGLU {
    int dummy;
    struct Pre { FixPre fx; };
    __device__ __forceinline__ Pre pre(int r, int pn, int wc, int fq) const { Pre p; p.fx = fix_pre<1>(r, pn, wc, fq); return p; }
    __device__ __forceinline__ void operator()(const f32x4 (&acc_)[2][2], int r, int pn, int wc, int fq, const Pre& p) const {
        f32x4 acc[2][2] = {{acc_[0][0], acc_[0][1]}, {acc_[1][0], acc_[1][1]}}; fix_apply(acc, p.fx);
        bf16* const O = (bf16*)(WSB() + WS_ACT0);
        const f32x4 g0 = acc[0][0], g1 = acc[0][1], u0 = acc[1][0], u1 = acc[1][1];
        v4u w; w.x = pg8::cvt_pk_bf16(pg8::silu_mul(g0[0], u0[0]), pg8::silu_mul(g0[1], u0[1])); w.y = pg8::cvt_pk_bf16(pg8::silu_mul(g0[2], u0[2]), pg8::silu_mul(g0[3], u0[3]));
        w.z = pg8::cvt_pk_bf16(pg8::silu_mul(g1[0], u1[0]), pg8::silu_mul(g1[1], u1[1])); w.w = pg8::cvt_pk_bf16(pg8::silu_mul(g1[2], u1[2]), pg8::silu_mul(g1[3], u1[3]));
        *(v4u*)(O + (size_t)r * FF0 + pn * 128 + wc * 32 + 8 * fq) = w;
    }
};

struct Frame {
    LAS unsigned char* lds;
    volatile LAS unsigned* MISC;
    gu32* ctl;
    int tid, lane, wave, vcu, G;
};
template <int CTRL> __device__ __forceinline__ float dppf(float v) { return __builtin_bit_cast(float, __builtin_amdgcn_update_dpp(0, __builtin_bit_cast(int, v), CTRL, 0xf, 0xf, true)); }
__device__ __forceinline__ float rdl(float v, int l) { return __builtin_bit_cast(float, __builtin_amdgcn_readlane(__builtin_bit_cast(int, v), l)); }
__device__ __forceinline__ float row_sum16(float v) { v += dppf<0xB1>(v); v += dppf<0x4E>(v); v += dppf<0x141>(v); v += dppf<0x140>(v); return v; }
__device__ __forceinline__ float wave_sum(float v) { v = row_sum16(v); return (rdl(v, 0) + rdl(v, 16)) + (rdl(v, 32) + rdl(v, 48)); }
template <int MAP> __device__ __forceinline__ int map_row(int n, int row_off) {
    if (MAP == 0) return row_off + n;
    if (MAP == 2) return row_off + 256 * (n >> 7) + (n & 127);
    const int pn = n >> 8; if (pn < 6 || pn > 9) return row_off + n;
    const int lc = n & 255, G = lc >> 6, dd = lc & 63, nn = dd >> 5, d = dd & 31, wcl = d >> 4, fq = (d & 15) >> 2, j = d & 3;
    const int bj = G >> 1, wc = (G & 1) * 2 + wcl;
    return row_off + 256 * pn + 128 * bj + 32 * wc + 8 * fq + 4 * nn + j;
}
template <int MAP> __device__ __forceinline__ void cvt_item(const float* W, int K, int N, bf16* WT, int row_off, LAS float* scr, int item, int lane) {
    const int nblk = N / 64, kb = item / nblk, nb = item % nblk, k0 = 64 * kb, n0 = 64 * nb;
    const int nq = lane & 15, kr = lane >> 4;
    const GAS float* wp = (const GAS float*)W + (size_t)(k0 + 2 * kr) * N + n0 + 4 * nq;
    f32x4 tv[16];
#pragma unroll
    for (int jj = 0; jj < 16; ++jj) tv[jj] = __builtin_nontemporal_load((const GAS f32x4*)(wp + (size_t)(8 * (jj >> 1) + (jj & 1)) * N));
    LAS unsigned* su = (LAS unsigned*)scr;
#pragma unroll
    for (int p = 0; p < 8; ++p) { const int kp = 4 * p + kr;
#pragma unroll
        for (int i = 0; i < 4; ++i) su[(4 * nq + i) * 33 + kp] = pk2(tv[2 * p][i], tv[2 * p + 1][i]); }
    LDS_WAIT(); asm volatile("" ::: "memory");
    const int c = lane & 7;
#pragma unroll
    for (int r = 0; r < 8; ++r) { const int n = (lane >> 3) + 8 * r; const LAS unsigned* s = su + n * 33 + 4 * c;
        v4u o; o.x = s[0]; o.y = s[1]; o.z = s[2]; o.w = s[3];
        *(GAS v4u*)(WT + (size_t)map_row<MAP>(n0 + n, row_off) * K + k0 + 8 * c) = o; }
    LDS_WAIT(); asm volatile("" ::: "memory");
}
template <int MAP> __device__ __forceinline__ void cvt_item_ln(const float* W, int K, int N, bf16* WT, int row_off, LAS float* scr, int item, int lane, const float* gv, const float* bv, int* c1, int* c0) {
    const int nblk = N / 64, kb = item / nblk, nb = item % nblk, k0 = 64 * kb, n0 = 64 * nb;
    const int nq = lane & 15, kr = lane >> 4;
    const GAS float* wp = (const GAS float*)W + (size_t)(k0 + 2 * kr) * N + n0 + 4 * nq;
    f32x4 tv[16];
#pragma unroll
    for (int jj = 0; jj < 16; ++jj) tv[jj] = __builtin_nontemporal_load((const GAS f32x4*)(wp + (size_t)(8 * (jj >> 1) + (jj & 1)) * N));
    f32x4 s1 = (f32x4){0.f, 0.f, 0.f, 0.f}, s0 = s1;
#pragma unroll
    for (int jj = 0; jj < 16; ++jj) { const int k = k0 + 2 * kr + 8 * (jj >> 1) + (jj & 1); const float gk = gv[k], bk = bv[k]; s0 += tv[jj] * bk; tv[jj] = tv[jj] * gk; s1 += tv[jj]; }
#pragma unroll
    for (int i = 0; i < 4; ++i) { s1[i] += __shfl_xor(s1[i], 16); s1[i] += __shfl_xor(s1[i], 32); s0[i] += __shfl_xor(s0[i], 16); s0[i] += __shfl_xor(s0[i], 32); }
    if (kr == 0) {
#pragma unroll
        for (int i = 0; i < 4; ++i) { const int d = map_row<MAP>(n0 + 4 * nq + i, row_off);
            __hip_atomic_fetch_add(c1 + d, __float2int_rn(s1[i] * 1048576.0f), __ATOMIC_RELAXED, __HIP_MEMORY_SCOPE_AGENT); __hip_atomic_fetch_add(c0 + d, __float2int_rn(s0[i] * 1048576.0f), __ATOMIC_RELAXED, __HIP_MEMORY_SCOPE_AGENT); } }
    LAS unsigned* su = (LAS unsigned*)scr;
#pragma unroll
    for (int p = 0; p < 8; ++p) { const int kp = 4 * p + kr;
#pragma unroll
        for (int i = 0; i < 4; ++i) su[(4 * nq + i) * 33 + kp] = pk2(tv[2 * p][i], tv[2 * p + 1][i]); }
    LDS_WAIT(); asm volatile("" ::: "memory");
    const int c = lane & 7;
#pragma unroll
    for (int r = 0; r < 8; ++r) { const int n = (lane >> 3) + 8 * r; const LAS unsigned* s = su + n * 33 + 4 * c;
        v4u o; o.x = s[0]; o.y = s[1]; o.z = s[2]; o.w = s[3];
        *(GAS v4u*)(WT + (size_t)map_row<MAP>(n0 + n, row_off) * K + k0 + 8 * c) = o; }
    LDS_WAIT(); asm volatile("" ::: "memory");
}
__device__ __forceinline__ void cvt8_load(const float* W, int N, int item, int lane, f32x4 (&tv)[16]) {
    const int nblk = N / 64, kb = item / nblk, nb = item % nblk, k0 = 64 * kb, n0 = 64 * nb;
    const int nq = lane & 15, kr = lane >> 4;
    const GAS float* wp = (const GAS float*)W + (size_t)(k0 + 4 * kr) * N + n0 + 4 * nq;
#pragma unroll
    for (int jj = 0; jj < 16; ++jj) tv[jj] = __builtin_nontemporal_load((const GAS f32x4*)(wp + (size_t)(16 * (jj >> 2) + (jj & 3)) * N));
}
template <int MAP, bool FOLD = false> __device__ __forceinline__ void cvt8_finish(f32x4 (&tv)[16], int K, int N, unsigned char* WT, int row_off, LAS float* scr, int item, int lane, float scale, const float* gv = nullptr) {
    const int nblk = N / 64, kb = item / nblk, nb = item % nblk, k0 = 64 * kb, n0 = 64 * nb;
    const int nq = lane & 15, kr = lane >> 4;
    if (FOLD) {
#pragma unroll
        for (int jj = 0; jj < 16; ++jj) tv[jj] = tv[jj] * gv[k0 + 4 * kr + 16 * (jj >> 2) + (jj & 3)]; }
    LAS unsigned* su = (LAS unsigned*)scr;
#pragma unroll
    for (int p = 0; p < 4; ++p) { const int kq = 4 * p + kr;
#pragma unroll
        for (int i = 0; i < 4; ++i) su[(4 * nq + i) * 17 + kq] = pk4_fp8(tv[4 * p][i] * scale, tv[4 * p + 1][i] * scale, tv[4 * p + 2][i] * scale, tv[4 * p + 3][i] * scale); }
    LDS_WAIT(); asm volatile("" ::: "memory");
    const int c = lane & 3;
#pragma unroll
    for (int r = 0; r < 4; ++r) { const int n = (lane >> 2) + 16 * r; const LAS unsigned* s = su + n * 17 + 4 * c;
        v4u o; o.x = s[0]; o.y = s[1]; o.z = s[2]; o.w = s[3];
        *(GAS v4u*)(WT + (size_t)map_row<MAP>(n0 + n, row_off) * K + k0 + 16 * c) = o; }
    LDS_WAIT(); asm volatile("" ::: "memory");
}
template <int MAP, bool FOLD = false> __device__ __forceinline__ void cvt_item8(const float* W, int K, int N, unsigned char* WT, int row_off, LAS float* scr, int item, int lane, float scale, const float* gv = nullptr) {
    f32x4 tv[16]; cvt8_load(W, N, item, lane, tv); cvt8_finish<MAP, FOLD>(tv, K, N, WT, row_off, scr, item, lane, scale, gv);
}
__device__ __forceinline__ void ln16(float (&v)[16], const float* g, const float* b, int lane) {
    float s = 0.f;
#pragma unroll
    for (int i = 0; i < 16; ++i) s += v[i];
    const float mean = wave_sum(s) * (1.f / 1024.f); float q = 0.f;
#pragma unroll
    for (int i = 0; i < 16; ++i) { v[i] -= mean; q += v[i] * v[i]; }
    const float rstd = __builtin_amdgcn_rsqf(wave_sum(q) * (1.f / 1024.f) + LN_EPS);
#pragma unroll
    for (int j = 0; j < 2; ++j) { const f32x4 g0 = *(const f32x4*)(g + 8 * lane + 512 * j), g1 = *(const f32x4*)(g + 8 * lane + 512 * j + 4), b0 = *(const f32x4*)(b + 8 * lane + 512 * j), b1 = *(const f32x4*)(b + 8 * lane + 512 * j + 4);
#pragma unroll
        for (int i = 0; i < 4; ++i) { v[8 * j + i] = v[8 * j + i] * rstd * g0[i] + b0[i]; v[8 * j + 4 + i] = v[8 * j + 4 + i] * rstd * g1[i] + b1[i]; } }
}
__device__ __forceinline__ void ln16r(float (&v)[16], const float (&gr)[16], const float (&br)[16]) {
    float s = 0.f;
#pragma unroll
    for (int i = 0; i < 16; ++i) s += v[i];
    const float mean = wave_sum(s) * (1.f / 1024.f); float q = 0.f;
#pragma unroll
    for (int i = 0; i < 16; ++i) { v[i] -= mean; q += v[i] * v[i]; }
    const float rstd = __builtin_amdgcn_rsqf(wave_sum(q) * (1.f / 1024.f) + LN_EPS);
#pragma unroll
    for (int i = 0; i < 16; ++i) v[i] = v[i] * rstd * gr[i] + br[i];
}
__device__ __forceinline__ void load_gb16(float (&gr)[16], const float* g, int lane) {
#pragma unroll
    for (int j = 0; j < 2; ++j) { const f32x4 a = *(const f32x4*)(g + 8 * lane + 512 * j), c = *(const f32x4*)(g + 8 * lane + 512 * j + 4);
        gr[8 * j + 0] = a[0]; gr[8 * j + 1] = a[1]; gr[8 * j + 2] = a[2]; gr[8 * j + 3] = a[3]; gr[8 * j + 4] = c[0]; gr[8 * j + 5] = c[1]; gr[8 * j + 6] = c[2]; gr[8 * j + 7] = c[3]; }
}
__device__ __forceinline__ void load16_bf16(float (&v)[16], const bf16* row, int lane) {
#pragma unroll
    for (int j = 0; j < 2; ++j) { const v4u w = *(const GAS v4u*)(row + 8 * lane + 512 * j);
        v[8 * j + 0] = bflo(w.x); v[8 * j + 1] = bfhi(w.x); v[8 * j + 2] = bflo(w.y); v[8 * j + 3] = bfhi(w.y); v[8 * j + 4] = bflo(w.z); v[8 * j + 5] = bfhi(w.z); v[8 * j + 6] = bflo(w.w); v[8 * j + 7] = bfhi(w.w); }
}
__device__ __forceinline__ void store16_bf16(const float (&v)[16], bf16* row, int lane) {
#pragma unroll
    for (int j = 0; j < 2; ++j) { v4u w; w.x = pk2(v[8 * j + 0], v[8 * j + 1]); w.y = pk2(v[8 * j + 2], v[8 * j + 3]); w.z = pk2(v[8 * j + 4], v[8 * j + 5]); w.w = pk2(v[8 * j + 6], v[8 * j + 7]);
        *(GAS v4u*)(row + 8 * lane + 512 * j) = w; }
}
__device__ __forceinline__ void zero_rows_bf16(bf16* base, int nrows, int ncols, int gw, int NGW, int lane) {
    for (int r = gw; r < nrows; r += NGW) for (int c = 8 * lane; c < ncols; c += 512) *(GAS v4u*)(base + (size_t)r * ncols + c) = (v4u){0u, 0u, 0u, 0u};
}


#ifndef PHSEL
#define PHSEL 0xffff
#endif
#define IN(k) (lo <= (k) && (k) < hi)
#define ING(k, g) (((PHSEL >> (g)) & 1) && IN(k))
#ifndef PROBE_DUP
#define PROBE_DUP 0
#endif
#define REPS(g) (((PROBE_DUP >> (g)) & 1) ? 2 : 1)
#define GRID_BAR(k) do { if (IN((k) + 1)) xcd_barrier(bar); } while (0)
#define PTRS() const int tid = fresh_tid(), lane = tid & 63; (void)tid; (void)lane; unsigned char* const ws = WSB(); unsigned char* const dout = DOB(); \
    bf16* const H = (bf16*)(ws + WS_H); bf16* const Qb = (bf16*)(ws + WS_Q); bf16* const Kb = (bf16*)(ws + WS_K); bf16* const Vb = (bf16*)(ws + WS_V); \
    bf16* const UB = (bf16*)(dout + DO_UB); bf16* const UC = (bf16*)(ws + WS_UC); bf16* const UH = (bf16*)(ws + WS_UH); \
    bf16* const OV = (bf16*)(dout + DO_OV); bf16* const CAT = (bf16*)(ws + WS_CAT); bf16* const PRE = (bf16*)(ws + WS_PRE); \
    float* const ropec = (float*)(ws + WS_ROPE_C); float* const ropes = (float*)(ws + WS_ROPE_S); \
    (void)H; (void)Qb; (void)Kb; (void)Vb; (void)UB; (void)UC; (void)UH; (void)OV; (void)CAT; (void)PRE; (void)ropec; (void)ropes; (void)dout

template <int layer> __device__ __forceinline__ void layer_body(Frame& F, const XcdBarrier& bar, const int lo, const int hi, unsigned char* lds) {
    const int wave = F.wave;
    const int gw = F.vcu * NWAVES + wave, NGW = F.G * NWAVES;
    {
        const int pb = 1 + 6 * layer;
        if (ING(pb, 1)) for (int rep = 0; rep < REPS(1); ++rep) {
            PTRS(); const bf16* const Win_t = (const bf16*)(ws + WS_WIN) + (size_t)layer * DIN * DM;
            pg8::Gemm g{H, Win_t, MMAIN_ROWS, DIN, DM}; pg8::StaticOrder S; S.init(MMAIN_ROWS, DIN, F.G, (int)blockIdx.x);
            if (layer == 1) zero_rows_bf16(Vb + (size_t)M * 512, 384, 512, gw, NGW, lane);
            pg8::EpiInProj<layer == 1> E{F.lds + RING_OFF};
            { const pg8::ListOrder SL = pg8::make_list(F.lds + RING_OFF, S, tid); pg8::gemm_phase<pg8::EpiInProj<layer == 1>, pg8::ListOrder, true, true>(F.lds + RING_OFF, g, SL, E); }
            for (int tr = 0; tr < REPS(14); ++tr) tail_gemm(H, Win_t, DM, DIN / 256, F.vcu, F.G, fresh_tid() & 63, wave, F.lds + RING_OFF, TailInProj<layer == 1>{0});
            GRID_BAR(pb);
        }
        if (ING(pb + 1, 2)) for (int rep = 0; rep < REPS(2); ++rep) {
            PTRS();
            gu32* const qctr = F.ctl + CW_QCTR + 64 * (layer + 2 * rep);
            constexpr int NATT = 17 * 64, NCONV = M / 128, NCONVB = (NCONV + 7) / 8, I_GM = 16 * 56, I_DM = 56 * 16, NCVT_ITEMS = 16 * I_GM + 8 * I_DM, NCVT = NCVT_ITEMS / 128, CVT0 = layer * NCVT;
            constexpr int I_IN = 16 * 48, I_OUT = 16 * 16, I_G0 = 16 * 44, I_D0 = 44 * 16, NW16_ITEMS = I_IN + 2 * I_OUT + 2 * (2 * I_G0 + I_D0), NW16 = (layer == 0) ? NW16_ITEMS / 64 : 0;
            constexpr int NAUX = NCONVB + NW16 + NCVT, NITEMS = NATT + NAUX;
            static_assert(NCVT_ITEMS % 128 == 0 && NW16_ITEMS % 64 == 0 && 3 * NAUX <= NATT, "aux batches");
            const float* const cw = AIN(5) + (size_t)layer * 3 * DCONV;
            unsigned nxt = 0;
            if (tid == 0) nxt = __hip_atomic_fetch_add(qctr, 1u, RLX_AGENT);
            for (;;) {
                if (tid == 0) F.MISC[16] = nxt;
                LDS_WAIT(); __builtin_amdgcn_s_barrier(); asm volatile("" ::: "memory");
                const int qi = (int)F.MISC[16];
                LDS_WAIT(); __builtin_amdgcn_s_barrier(); asm volatile("" ::: "memory");
                if (qi >= NITEMS) break;
                if (tid == 0) nxt = __hip_atomic_fetch_add(qctr, 1u, RLX_AGENT);
                int it = qi - NAUX, aux = -1;
                if (qi < 4 * NAUX) { const int j = qi >> 2, r = qi & 3; if (r == 3) aux = j; else it = 3 * j + r; }
                if (aux >= NCONVB && aux < NCONVB + NW16) {
                    LAS float* scr = (LAS float*)(F.lds + RING_OFF + wave * 16384); const int lane = fresh_tid() & 63;
                    bf16* const Win_t = (bf16*)(ws + WS_WIN); bf16* const Wout_t = (bf16*)(ws + WS_WOUT); bf16* const Wgu0 = (bf16*)(ws + WS_WGU0); bf16* const Wd0 = (bf16*)(ws + WS_WD0);
#pragma unroll 1
                    for (int k = 0; k < 8; ++k) { int g = (aux - NCONVB) * 64 + k * 8 + wave;
                        int* const cvb_ = (int*)(ws + WS_CTL + CV_OFF);
                        if (g < I_IN) { cvt_item_ln<1>(AIN(4) + (size_t)DM * DIN, DM, DIN, Win_t + (size_t)DIN * DM, 0, scr, g, lane, AIN(14), AIN(15), cvb_ + CV_C1IN, cvb_ + CV_C0IN); continue; } g -= I_IN;
                        if (g < 2 * I_OUT) { const int l = g / I_OUT, r = g % I_OUT; cvt_item<0>(AIN(11) + (size_t)l * DM * DM, DM, DM, Wout_t + (size_t)l * DM * DM, 0, scr, r, lane); continue; } g -= 2 * I_OUT;
                        if (g < 2 * I_G0) { const int w = g / I_G0, r = g % I_G0; cvt_item_ln<2>(AIN(16 + w), DM, FF0, Wgu0, 128 * w, scr, r, lane, AIN(12), AIN(13), cvb_ + CV_C1GU, cvb_ + CV_C0GU); continue; } g -= 2 * I_G0;
                        if (g < I_D0) { cvt_item<0>(AIN(18), FF0, DM, Wd0, 0, scr, g, lane); continue; } g -= I_D0;
                        if (g < 2 * I_G0) { const int w = g / I_G0, r = g % I_G0; cvt_item8<2, true>(AIN(16 + w), DM, FF0, ws + WS_WGU0_8, 128 * w, scr, r, lane, WS_GU, AIN(12)); continue; } g -= 2 * I_G0;
                        cvt_item8<0>(AIN(18), FF0, DM, ws + WS_WD0_8, 0, scr, g, lane, WS_DN); }
                } else if (aux >= NCONVB + NW16) {
                    const int cvb = CVT0 + aux - NCONVB - NW16;
                    LAS float* scr = (LAS float*)(F.lds + RING_OFF + wave * 16384); const int lane = fresh_tid() & 63;
                    unsigned char* const Wmgu = ws + WS_WMOE_GU; unsigned char* const Wmd = ws + WS_WMOE_D;
#pragma unroll 1
                    for (int k = 0; k < 8; k += 2) { const int ci = cvb * 64 + k * 8 + wave, cj = ci + 8;
                        f32x4 ta[16], tb[16];
                        if (ci < 16 * I_GM) { const int ew = ci / I_GM, r = ci % I_GM, r2 = cj % I_GM, e = ew >> 1, w = ew & 1; const float* W = AIN(20 + w) + (size_t)e * DM * FFE;
                            cvt8_load(W, FFE, r, lane, ta); cvt8_load(W, FFE, r2, lane, tb);
                            cvt8_finish<2>(ta, DM, FFE, Wmgu, e * 2 * FFE + 128 * w, scr, r, lane, WS_GU); cvt8_finish<2>(tb, DM, FFE, Wmgu, e * 2 * FFE + 128 * w, scr, r2, lane, WS_GU); }
                        else { const int q = ci - 16 * I_GM, e = q / I_DM, r = q % I_DM, r2 = (q + 8) % I_DM; const float* W = AIN(22) + (size_t)e * FFE * DM;
                            cvt8_load(W, DM, r, lane, ta); cvt8_load(W, DM, r2, lane, tb);
                            cvt8_finish<0>(ta, FFE, DM, Wmd, e * DM, scr, r, lane, WS_DN); cvt8_finish<0>(tb, FFE, DM, Wmd, e * DM, scr, r2, lane, WS_DN); } }
                } else if (aux < 0) {
                    const int qb = 16 - (it >> 6), bhc = it & 63, b = bhc >> 3, hc = bhc & 7;
                    if (qb == 16) attn3::attn_tail_unit((long)b * LSEQ, 4096, LSEQ, (const attn3::bf16*)(Qb + hc * 64), (const attn3::bf16*)(Kb + hc * 64), (const attn3::bf16*)(Vb + (hc >> 1) * 128), (attn3::bf16*)(OV + hc * 128), (char*)lds + RING_OFF);
                    else attn3::attn_unit<ATTN_THRL>((long)b * LSEQ, qb, LSEQ, (const attn3::bf16*)(Qb + hc * 64), (const attn3::bf16*)(Kb + hc * 64), (const attn3::bf16*)(Vb + (hc >> 1) * 128), (attn3::bf16*)(OV + hc * 128), (char*)lds + RING_OFF);
                } else {
                    const int lane = fresh_tid() & 63;
#pragma unroll 1
                    for (int ck = 0; ck < 8; ++ck) { const int citem = aux * 8 + ck; if (citem >= NCONV) break;
                    const int r0 = citem * 128 + wave * 16, t0 = r0 % LSEQ, ch = 8 * lane;
                    float w0[8], w1[8], w2[8];
#pragma unroll
                    for (int i = 0; i < 8; ++i) { w0[i] = cw[ch + i]; w1[i] = cw[DCONV + ch + i]; w2[i] = cw[2 * DCONV + ch + i]; }
                    float vm1[8], vm2[8];
#pragma unroll
                    for (int i = 0; i < 8; ++i) { vm1[i] = 0.f; vm2[i] = 0.f; }
                    if (t0 >= 2) {
#pragma unroll
                        for (int k = 1; k <= 2; ++k) { const v4u a = *(const GAS v4u*)(UC + (size_t)(r0 - k) * 512 + ch), c = *(const GAS v4u*)(UH + (size_t)(r0 - k) * 512 + ch);
                            float* dst = (k == 1) ? vm1 : vm2;
                            dst[0] = bflo(a.x) * bflo(c.x); dst[1] = bfhi(a.x) * bfhi(c.x); dst[2] = bflo(a.y) * bflo(c.y); dst[3] = bfhi(a.y) * bfhi(c.y);
                            dst[4] = bflo(a.z) * bflo(c.z); dst[5] = bfhi(a.z) * bfhi(c.z); dst[6] = bflo(a.w) * bflo(c.w); dst[7] = bfhi(a.w) * bfhi(c.w); }
                    }
#pragma unroll 1
                    for (int i4 = 0; i4 < 16; i4 += 4) {
                        v4u ua[4], uc[4], ubv[4];
#pragma unroll
                        for (int k = 0; k < 4; ++k) { const size_t ro = (size_t)(r0 + i4 + k) * 512 + ch; ua[k] = *(const GAS v4u*)(UC + ro); uc[k] = *(const GAS v4u*)(UH + ro); ubv[k] = *(const GAS v4u*)(UB + ro); }
#pragma unroll
                        for (int k = 0; k < 4; ++k) { const int i = i4 + k; const v4u a = ua[k], c = uc[k], ub = ubv[k];
                        float v[8], bb[8], y[8];
                        v[0] = bflo(a.x) * bflo(c.x); v[1] = bfhi(a.x) * bfhi(c.x); v[2] = bflo(a.y) * bflo(c.y); v[3] = bfhi(a.y) * bfhi(c.y);
                        v[4] = bflo(a.z) * bflo(c.z); v[5] = bfhi(a.z) * bfhi(c.z); v[6] = bflo(a.w) * bflo(c.w); v[7] = bfhi(a.w) * bfhi(c.w);
                        bb[0] = bflo(ub.x); bb[1] = bfhi(ub.x); bb[2] = bflo(ub.y); bb[3] = bfhi(ub.y); bb[4] = bflo(ub.z); bb[5] = bfhi(ub.z); bb[6] = bflo(ub.w); bb[7] = bfhi(ub.w);
#pragma unroll
                        for (int q = 0; q < 8; ++q) { y[q] = bb[q] * (w0[q] * vm2[q] + w1[q] * vm1[q] + w2[q] * v[q]); vm2[q] = vm1[q]; vm1[q] = v[q]; }
                        v4u o; o.x = pk2(y[0], y[1]); o.y = pk2(y[2], y[3]); o.z = pk2(y[4], y[5]); o.w = pk2(y[6], y[7]);
                        *(GAS v4u*)(CAT + (size_t)(r0 + i) * DM + ch) = o; } }
                    }
                }
            }
            GRID_BAR(pb + 1);
        }
        if (ING(pb + 2, 3)) for (int rep = 0; rep < REPS(3); ++rep) {
            PTRS();
            const float li = layer == 0 ? 0.2f : 0.35550906759f;
            const float a1 = AIN(6)[layer * 64 + lane] * AIN(7)[layer * 64 + lane], a2 = AIN(8)[layer * 64 + lane] * AIN(9)[layer * 64 + lane];
            const float lam = expf(wave_sum(a1)) - expf(wave_sum(a2)) + li;
            const int h = lane >> 4, sub = lane & 15;
            const f32x4 g0 = *(const f32x4*)(AIN(10) + layer * 128 + sub * 8), g1 = *(const f32x4*)(AIN(10) + layer * 128 + sub * 8 + 4);
            for (int m0 = gw; m0 < M; m0 += 4 * NGW) {
                v4u pp[4], qq[4];
#pragma unroll
                for (int k = 0; k < 4; ++k) { const int m = m0 + k * NGW; if (m < M) { pp[k] = *(const GAS v4u*)(OV + (size_t)m * 1024 + h * 256 + sub * 8); qq[k] = *(const GAS v4u*)(OV + (size_t)m * 1024 + h * 256 + 128 + sub * 8); } }
#pragma unroll
                for (int k = 0; k < 4; ++k) { const int m = m0 + k * NGW; if (m < M) { const v4u p = pp[k], q = qq[k];
                float o[8];
                o[0] = bflo(p.x) - lam * bflo(q.x); o[1] = bfhi(p.x) - lam * bfhi(q.x); o[2] = bflo(p.y) - lam * bflo(q.y); o[3] = bfhi(p.y) - lam * bfhi(q.y);
                o[4] = bflo(p.z) - lam * bflo(q.z); o[5] = bfhi(p.z) - lam * bfhi(q.z); o[6] = bflo(p.w) - lam * bflo(q.w); o[7] = bfhi(p.w) - lam * bfhi(q.w);
                float s = 0.f;
#pragma unroll
                for (int i = 0; i < 8; ++i) s += o[i] * o[i];
                s = row_sum16(s);
                const float sc = __builtin_amdgcn_rsqf(s * (1.f / 128.f) + RMS_EPS) * (1.0f - li);
                v4u w; w.x = pk2(o[0] * sc * g0[0], o[1] * sc * g0[1]); w.y = pk2(o[2] * sc * g0[2], o[3] * sc * g0[3]); w.z = pk2(o[4] * sc * g1[0], o[5] * sc * g1[1]); w.w = pk2(o[6] * sc * g1[2], o[7] * sc * g1[3]);
                *(GAS v4u*)(CAT + (size_t)m * DM + 512 + h * 128 + sub * 8) = w; } }
            }
            GRID_BAR(pb + 2);
        }
        if (ING(pb + 3, 4)) for (int rep = 0; rep < REPS(4); ++rep) {
            PTRS(); const bf16* const Wout_t = (const bf16*)(ws + WS_WOUT) + (size_t)layer * DM * DM;
            pg8::Gemm g{CAT, Wout_t, MMAIN_ROWS, DM, DM}; pg8::StaticOrder S; S.init(MMAIN_ROWS, DM, F.G, (int)blockIdx.x);
            constexpr int RM = layer == 0 ? 0 : 2;
            pg8::EpiResid<RM> E{0};
            { const pg8::ListOrder SL = pg8::make_list(F.lds + RING_OFF, S, tid); pg8::gemm_phase<pg8::EpiResid<RM>, pg8::ListOrder, true, true>(F.lds + RING_OFF, g, SL, E); }
            for (int tr = 0; tr < REPS(14); ++tr) tail_gemm(CAT, Wout_t, DM, DM / 256, F.vcu, F.G, fresh_tid() & 63, wave, F.lds + RING_OFF, TailResid<RM>{0});
            GRID_BAR(pb + 3);
        }
        if (layer == 0) {
            if (ING(5, 6)) for (int rep = 0; rep < REPS(6); ++rep) {
                PTRS();
                pg8::Gemm g{(const bf16*)(ws + WS_X8), (const bf16*)(ws + WS_WGU0_8), MMAIN_ROWS, 2 * FF0, DM / 2}; pg8::StaticOrder S; S.init(MMAIN_ROWS, 2 * FF0, F.G, (int)blockIdx.x);
                pg8::EpiSwiGLU E{F.lds + RING_OFF};
                { const pg8::ListOrder SL = pg8::make_list(F.lds + RING_OFF, S, tid); pg8::gemm_phase<pg8::EpiSwiGLU, pg8::ListOrder, true, true, true>(F.lds + RING_OFF, g, SL, E); }
                for (int tr = 0; tr < REPS(14); ++tr) tail_gemm(H, (const bf16*)(ws + WS_WGU0), DM, 2 * FF0 / 256, F.vcu, F.G, fresh_tid() & 63, wave, F.lds + RING_OFF, TailSwiGLU{0});
                GRID_BAR(5);
            }
            if (ING(6, 7)) for (int rep = 0; rep < REPS(7); ++rep) {
                PTRS();
                pg8::Gemm g{(const bf16*)(ws + WS_ACT0), (const bf16*)(ws + WS_WD0_8), MMAIN_ROWS, DM, FF0 / 2}; pg8::StaticOrder S; S.init(MMAIN_ROWS, DM, F.G, (int)blockIdx.x);
                pg8::EpiResid<1> E{0};
                { const pg8::ListOrder SL = pg8::make_list(F.lds + RING_OFF, S, tid); pg8::gemm_phase<pg8::EpiResid<1>, pg8::ListOrder, true, true, true>(F.lds + RING_OFF, g, SL, E); }
                for (int tr = 0; tr < REPS(14); ++tr) tail_gemm((const bf16*)(ws + WS_ACT0), (const bf16*)(ws + WS_WD0), FF0, DM / 256, F.vcu, F.G, fresh_tid() & 63, wave, F.lds + RING_OFF, TailResid<1>{0});
                GRID_BAR(6);
            }
        } else {
#define MPTRS() PTRS(); int* const tokinfo = (int*)(ws + WS_TOKINFO); int* const rowinfo = (int*)(ws + WS_ROWINFO); \
            unsigned char* const ASORT = ws + WS_ASORT; bf16* const OS = (bf16*)(ws + WS_OUTSLOT); unsigned char* const ACTC = dout + DO_ACT; unsigned char* const H8 = ws + WS_H8; (void)H8; \
            (void)tokinfo; (void)rowinfo; (void)ASORT; (void)OS; (void)ACTC
            if (ING(11, 9)) {
                MPTRS();
                const float* g = AIN(12) + DM; const float* b = AIN(13) + DM; const float* Wr = AIN(19);
                LAS float* wl = (LAS float*)(F.lds + RING_OFF);
                for (int idx = tid; idx < DM * NEXP; idx += NTHREADS) { const int k = idx >> 3, e = idx & 7, ln = (k & 511) >> 3, j = k >> 9, i = k & 7;
                    wl[((((j * 8 + i) * 2 + (e >> 2)) * 64 + ln) << 2) + (e & 3)] = Wr[idx]; }
                __syncthreads();
                float gr[16], br[16]; load_gb16(gr, g, lane); load_gb16(br, b, lane);
                for (int base = gw; base < MMAIN; base += 64 * NGW) {
                    int me0 = 0, me1 = 0, mtok = -1; float mg0 = 0.f, mg1 = 0.f;
                    v4u nr0, nr1;
                    { const int m = (base >> 12) * LSEQ + NMETA + (base & 4095); nr0 = *(const GAS v4u*)(PRE + (size_t)m * DM + 8 * lane); nr1 = *(const GAS v4u*)(PRE + (size_t)m * DM + 512 + 8 * lane); }
                    for (int i = 0; i < 64; ++i) { const int tok = base + i * NGW; if (tok >= MMAIN) break;
                        const int m = (tok >> 12) * LSEQ + NMETA + (tok & 4095);
                        float v[16];
                        v[0] = bflo(nr0.x); v[1] = bfhi(nr0.x); v[2] = bflo(nr0.y); v[3] = bfhi(nr0.y); v[4] = bflo(nr0.z); v[5] = bfhi(nr0.z); v[6] = bflo(nr0.w); v[7] = bfhi(nr0.w);
                        v[8] = bflo(nr1.x); v[9] = bfhi(nr1.x); v[10] = bflo(nr1.y); v[11] = bfhi(nr1.y); v[12] = bflo(nr1.z); v[13] = bfhi(nr1.z); v[14] = bflo(nr1.w); v[15] = bfhi(nr1.w);
                        { const int tn = tok + NGW; if (tn < MMAIN && i + 1 < 64) { const int mn = (tn >> 12) * LSEQ + NMETA + (tn & 4095); nr0 = *(const GAS v4u*)(PRE + (size_t)mn * DM + 8 * lane); nr1 = *(const GAS v4u*)(PRE + (size_t)mn * DM + 512 + 8 * lane); } }
                        ln16r(v, gr, br); store16_bf16(v, H + (size_t)m * DM, lane);
#pragma unroll
                        for (int j = 0; j < 2; ++j) { v2u w; w.x = pk4_fp8(v[8 * j], v[8 * j + 1], v[8 * j + 2], v[8 * j + 3]); w.y = pk4_fp8(v[8 * j + 4], v[8 * j + 5], v[8 * j + 6], v[8 * j + 7]);
                            *(GAS v2u*)(H8 + (size_t)tok * DM + 8 * lane + 512 * j) = w; }
                        typedef float f32x2r __attribute__((ext_vector_type(2)));
                        f32x2r lp[4] = {{0.f, 0.f}, {0.f, 0.f}, {0.f, 0.f}, {0.f, 0.f}};
#pragma unroll
                        for (int q = 0; q < 16; ++q) { const f32x4 wa = *(const LAS f32x4*)(wl + (((q * 2 + 0) * 64 + lane) << 2)), wb = *(const LAS f32x4*)(wl + (((q * 2 + 1) * 64 + lane) << 2));
                            const f32x2r vv = {v[q], v[q]};
                            lp[0] += vv * (f32x2r){wa[0], wa[1]}; lp[1] += vv * (f32x2r){wa[2], wa[3]}; lp[2] += vv * (f32x2r){wb[0], wb[1]}; lp[3] += vv * (f32x2r){wb[2], wb[3]}; }
                        float s4[4];
                        { const float p8[8] = {lp[0].x, lp[0].y, lp[1].x, lp[1].y, lp[2].x, lp[2].y, lp[3].x, lp[3].y};
#pragma unroll
                          for (int a = 0; a < 4; ++a) { auto r = __builtin_amdgcn_permlane32_swap(__float_as_uint(p8[a]), __float_as_uint(p8[a + 4]), false, false); const unsigned r0 = r[0], r1 = r[1]; s4[a] = __uint_as_float(r0) + __uint_as_float(r1); } }
                        float t2[2];
#pragma unroll
                        for (int a = 0; a < 2; ++a) { auto r = __builtin_amdgcn_permlane16_swap(__float_as_uint(s4[a]), __float_as_uint(s4[a + 2]), false, false); const unsigned r0 = r[0], r1 = r[1]; t2[a] = __uint_as_float(r0) + __uint_as_float(r1); }
                        float tot;
                        { const bool b3 = (lane & 8) != 0; const float sel = b3 ? t2[1] : t2[0], oth = b3 ? t2[0] : t2[1];
                          tot = sel + dppf<0x128>(oth);
                          tot += dppf<0xB1>(tot); tot += dppf<0x4E>(tot); tot += dppf<0x141>(tot); }
                        float lg[8];
#pragma unroll
                        for (int e = 0; e < 8; ++e) lg[e] = rdl(tot, 8 * e);
                        int e0 = 0; float v0 = lg[0];
#pragma unroll
                        for (int e = 1; e < 8; ++e) if (lg[e] > v0) { v0 = lg[e]; e0 = e; }
                        int e1 = -1; float v1 = -INFINITY;
#pragma unroll
                        for (int e = 0; e < 8; ++e) if (e != e0 && lg[e] > v1) { v1 = lg[e]; e1 = e; }
                        const float g0 = __builtin_amdgcn_rcpf(1.0f + __builtin_amdgcn_exp2f((v1 - v0) * 1.4426950408889634f));
                        if (lane == i) { me0 = e0; me1 = e1; mtok = tok; mg0 = g0; mg1 = 1.0f - g0; }
                    }
                    const bool valid = mtok >= 0; unsigned mybase = 0; int mycnt = 0; int rank0 = 0, rank1 = 0;
                    const unsigned long long ltmask = (1ull << lane) - 1ull;
#pragma unroll
                    for (int e = 0; e < 8; ++e) { const unsigned long long m0 = __ballot(valid && me0 == e), m1 = __ballot(valid && me1 == e);
                        const int c0 = __popcll(m0), c1 = __popcll(m1);
                        if (lane == e) mycnt = c0 + c1;
                        if (me0 == e) rank0 = __popcll(m0 & ltmask);
                        if (me1 == e) rank1 = c0 + __popcll(m1 & ltmask); }
                    if (lane < 8 && mycnt > 0) mybase = __hip_atomic_fetch_add(F.ctl + CW_CNT + 64 * lane, (unsigned)mycnt, RLX_AGENT);
                    const int p0 = (int)__shfl(mybase, me0) + rank0, p1 = (int)__shfl(mybase, me1) + rank1;
                    if (valid) { typedef int i32x2v __attribute__((ext_vector_type(2)));
                        *(GAS i32x2v*)(rowinfo + 2 * ((size_t)me0 * MOE_CAPR + p0)) = (i32x2v){mtok * 2, __builtin_bit_cast(int, mg0)};
                        *(GAS i32x2v*)(rowinfo + 2 * ((size_t)me1 * MOE_CAPR + p1)) = (i32x2v){mtok * 2 + 1, __builtin_bit_cast(int, mg1)}; }
                }
                GRID_BAR(11);
            }
            int T = 0;
            if (hi > 12) {
                int te[8];
#pragma unroll
                for (int e = 0; e < 8; ++e) { const unsigned c = __hip_atomic_load(F.ctl + CW_CNT + 64 * e, RLX_AGENT); T += (int)((c + 255u) >> 8); te[e] = T; }
                if (threadIdx.x == 0) {
#pragma unroll
                    for (int e = 0; e < 8; ++e) F.MISC[32 + e] = (unsigned)te[e]; }
                __syncthreads();
                T = __builtin_amdgcn_readfirstlane((int)F.MISC[39]);
            }
#define TE(k) ((int)F.MISC[32 + (k)])
            {
                constexpr int c = 0; const int t0 = 0; const int ntl = T < MOE_CH ? T : MOE_CH;
                if (ING(13 + 2 * c, 11)) for (int rep = 0; rep < REPS(11); ++rep) {
                    MPTRS();
                    pg8::Gemm g{(const bf16*)H8, (const bf16*)(ws + WS_WMOE_GU), 0, 0, DM / 2, rowinfo};
                    pg8::MoeOrder<true> S{F.lds, t0, ntl, 28, F.G, (int)blockIdx.x};
                    pg8::EpiSwiGLU8 E{F.lds, t0};
                    { const pg8::ListOrder SL = pg8::make_list(F.lds + RING_OFF, S, tid); pg8::gemm_phase<pg8::EpiSwiGLU8, pg8::ListOrder, MOE_ALIGN, MOE_SP2, true, true>(F.lds + RING_OFF, g, SL, E); }
                    GRID_BAR(13 + 2 * c);
                }
                if (ING(14 + 2 * c, 12)) for (int rep = 0; rep < REPS(12); ++rep) {
                    MPTRS();
                    pg8::Gemm g{(const bf16*)ACTC, (const bf16*)(ws + WS_WMOE_D), 0, 0, FFE / 2, nullptr, (const bf16*)(ws + WS_ACT2), MOE_NA1};
                    pg8::EpiMoeDown E{F.lds, t0};
                    const int nwg = ntl * 4, R = nwg / F.G, left = nwg - R * F.G;
                    if (left > 0 && left <= 32) {
                        { pg8::MoeOrder<false> S{F.lds, t0, ntl, 4, F.G, (int)blockIdx.x, 0, R};
                          const pg8::ListOrder SL = pg8::make_list(F.lds + RING_OFF, S, tid); pg8::gemm_phase<pg8::EpiMoeDown, pg8::ListOrder, true, MOE_SP2, true>(F.lds + RING_OFF, g, SL, E); }
                        float* const part = (float*)(ws + WS_PART);
                        { pg8::MoeOrder<false> S{F.lds, t0, ntl, 4, F.G, (int)blockIdx.x, 0, 1 << 30, R * F.G};
                          pg8::Gemm gs{(const bf16*)ACTC, (const bf16*)(ws + WS_WMOE_D), (FFE / 128) / pg8::MOE_NSL, 0, FFE / 2, nullptr, (const bf16*)(ws + WS_ACT2), MOE_NA1};
                          pg8::EpiPartial EP{part};
                          const pg8::ListOrder SL = pg8::make_list(F.lds + RING_OFF, S, tid); pg8::gemm_phase<pg8::EpiPartial, pg8::ListOrder, true, MOE_SP2, true, false, true>(F.lds + RING_OFF, gs, SL, EP); }
                        xcd_barrier(bar);
                        {
                          const pg8::MoeOrder<false> S{F.lds, t0, ntl, 4, F.G, 0, 0, 1 << 30, R * F.G};
                          const int ltid = fresh_tid(), lw = ltid >> 6, ll = ltid & 63, wr = lw >> 2, wc = lw & 3, fr = ll & 15, fq = ll >> 4;
                          bf16* const OSb = (bf16*)(ws + WS_OUTSLOT);
                          for (int it = (int)blockIdx.x; it < left * 16; it += F.G) { const int ul = it >> 4, q = it & 15, ai = q >> 3, bj = (q >> 2) & 1, m = q & 3;
                              int pml, pc, e, pte; S.decode(R * F.G + ul, pml, pc, e, pte); const int tg = t0 + pml;
                              f32x4 s0 = (f32x4){0.f, 0.f, 0.f, 0.f}, s1 = s0;
                              const float* pb = part + (size_t)(ul * pg8::MOE_NSL) * 65536 + (size_t)(q * 2) * 2048 + 4 * ltid;
                              f32x4 p0[pg8::MOE_NSL], p1[pg8::MOE_NSL];
#pragma unroll
                              for (int sl = 0; sl < pg8::MOE_NSL; ++sl) { p0[sl] = *(const GAS f32x4*)(pb + (size_t)sl * 65536); p1[sl] = *(const GAS f32x4*)(pb + (size_t)sl * 65536 + 2048); }
#pragma unroll
                              for (int sl = 0; sl < pg8::MOE_NSL; ++sl) { s0 += p0[sl]; s1 += p1[sl]; }
                              const int vrow = (e * MOE_CAPT + (tg - pte)) * 256 + ai * 128 + wr * 64 + m * 16 + fr;
                              const v2u ri = *(const GAS v2u*)(rowinfo + 2 * vrow); const unsigned rx = ri.x, ry = ri.y; const int ts = (int)rx; const float gt = __uint_as_float(ry) * (OS_SC / WS_DN);
                              if (ts >= 0) { unsigned char* rowp = (unsigned char*)OSb + ((size_t)(ts & 1) * MMAIN + (size_t)(ts >> 1)) * 1024 + pc * 256 + bj * 128 + wc * 32 + 8 * fq;
                                  const f32x4 v0 = s0 * gt, v1 = s1 * gt;
                                  v2u w; w.x = pk4_fp8(v0[0], v0[1], v0[2], v0[3]); w.y = pk4_fp8(v1[0], v1[1], v1[2], v1[3]);
                                  *(GAS v2u*)rowp = w; } } }
                    } else {
                        pg8::MoeOrder<false> S{F.lds, t0, ntl, 4, F.G, (int)blockIdx.x};
                        const pg8::ListOrder SL = pg8::make_list(F.lds + RING_OFF, S, tid); pg8::gemm_phase<pg8::EpiMoeDown, pg8::ListOrder, true, MOE_SP2, true>(F.lds + RING_OFF, g, SL, E);
                    }
                    GRID_BAR(14 + 2 * c);
                }
            }
            if (ING(17, 13)) for (int rep = 0; rep < REPS(13); ++rep) {
                MPTRS();
                const float* g = AIN(14) + DM; const float* b = AIN(15) + DM;
                v4u rh[2][2]; v2u ra[2][2], rb[2][2];
#define FIN_ISSUE(T0) do { _Pragma("unroll") for (int q = 0; q < 2; ++q) { const int tok = (T0) + q * NGW; if (tok < MMAIN) { const int m = (tok >> 12) * LSEQ + NMETA + (tok & 4095); \
                    _Pragma("unroll") for (int j = 0; j < 2; ++j) { rh[q][j] = *(const GAS v4u*)(H + (size_t)m * DM + 8 * lane + 512 * j); ra[q][j] = *(const GAS v2u*)((const unsigned char*)OS + (size_t)tok * DM + 8 * lane + 512 * j); \
                        rb[q][j] = *(const GAS v2u*)((const unsigned char*)OS + ((size_t)MMAIN + tok) * DM + 8 * lane + 512 * j); } } } } while (0)
#define FIN_UNPK(dst, W_, j) do { dst[8 * (j) + 0] = bflo(W_.x); dst[8 * (j) + 1] = bfhi(W_.x); dst[8 * (j) + 2] = bflo(W_.y); dst[8 * (j) + 3] = bfhi(W_.y); dst[8 * (j) + 4] = bflo(W_.z); dst[8 * (j) + 5] = bfhi(W_.z); dst[8 * (j) + 6] = bflo(W_.w); dst[8 * (j) + 7] = bfhi(W_.w); } while (0)
                float gr[16], br[16]; load_gb16(gr, g, lane); load_gb16(br, b, lane);
#define FIN_UNPK8(dst, W_, j) do { typedef float f32x2u __attribute__((ext_vector_type(2))); const unsigned wx_ = W_.x, wy_ = W_.y; \
                    const f32x2u a_ = __builtin_amdgcn_cvt_pk_f32_fp8((int)wx_, false), b_ = __builtin_amdgcn_cvt_pk_f32_fp8((int)wx_, true), c_ = __builtin_amdgcn_cvt_pk_f32_fp8((int)wy_, false), d_ = __builtin_amdgcn_cvt_pk_f32_fp8((int)wy_, true); \
                    dst[8 * (j) + 0] = a_.x * (1.0f / OS_SC); dst[8 * (j) + 1] = a_.y * (1.0f / OS_SC); dst[8 * (j) + 2] = b_.x * (1.0f / OS_SC); dst[8 * (j) + 3] = b_.y * (1.0f / OS_SC); \
                    dst[8 * (j) + 4] = c_.x * (1.0f / OS_SC); dst[8 * (j) + 5] = c_.y * (1.0f / OS_SC); dst[8 * (j) + 6] = d_.x * (1.0f / OS_SC); dst[8 * (j) + 7] = d_.y * (1.0f / OS_SC); } while (0)
                FIN_ISSUE(gw);
                for (int tok0 = gw; tok0 < MMAIN; tok0 += 2 * NGW) {
                    float v[2][16];
#pragma unroll
                    for (int q = 0; q < 2; ++q) { float s0[16], s1[16];
#pragma unroll
                        for (int j = 0; j < 2; ++j) { const v4u wh = rh[q][j]; const v2u wa = ra[q][j], wb = rb[q][j]; FIN_UNPK(v[q], wh, j); FIN_UNPK8(s0, wa, j); FIN_UNPK8(s1, wb, j); }
#pragma unroll
                        for (int i = 0; i < 16; ++i) v[q][i] = ALPHA * v[q][i] + (s0[i] + s1[i]); }
                    if (tok0 + 2 * NGW < MMAIN) FIN_ISSUE(tok0 + 2 * NGW);
#pragma unroll
                    for (int q = 0; q < 2; ++q) { const int tok = tok0 + q * NGW; if (tok < MMAIN) {
                        ln16r(v[q], gr, br);
                        float* orow = (float*)dout + (size_t)tok * DM;
#pragma unroll
                        for (int j = 0; j < 2; ++j) { *(GAS f32x4*)(orow + 8 * lane + 512 * j) = (f32x4){v[q][8 * j], v[q][8 * j + 1], v[q][8 * j + 2], v[q][8 * j + 3]}; *(GAS f32x4*)(orow + 8 * lane + 512 * j + 4) = (f32x4){v[q][8 * j + 4], v[q][8 * j + 5], v[q][8 * j + 6], v[q][8 * j + 7]}; } } }
                }
#undef FIN_ISSUE
#undef FIN_UNPK
#undef FIN_UNPK8
                if (rep + 1 < REPS(13)) xcd_barrier(bar);
            }
        }
    }
}

__global__ void __launch_bounds__(NTHREADS, 2) hybrid_fwd(Args args_unused) {
    extern __shared__ __attribute__((aligned(16))) unsigned char lds[];
    Frame F;
    F.lds = (LAS unsigned char*)lds;
    F.MISC = (volatile LAS unsigned*)(F.lds + MISC_OFF);
    F.tid = threadIdx.x; F.lane = F.tid & 63; F.wave = __builtin_amdgcn_readfirstlane(F.tid >> 6);
    F.G = gridDim.x; { const int bx = blockIdx.x; F.vcu = (F.G % 8 == 0) ? (bx % 8) * (F.G / 8) + bx / 8 : bx; }
    F.ctl = (gu32*)(WSB() + WS_CTL);
    const int wave = F.wave;
    const int gw = F.vcu * NWAVES + wave, NGW = F.G * NWAVES;
    for (int u = F.tid; u < (LDS_BYTES - LDSCTL_OFF) / 4; u += NTHREADS) ((LAS unsigned*)(F.lds + LDSCTL_OFF))[u] = 0u;
    __syncthreads();
#if MK_PER_PHASE
    const int lo = kargs()->ph_lo, hi = kargs()->ph_hi;
#else
    constexpr int lo = 0, hi = NPHASES;
#endif
    const bool one_launch = (lo == 0 && hi == NPHASES);
    XcdBarrier bar; bar.bar = (unsigned*)(F.ctl + CW_BAR); bar.x = 0; bar.st = nullptr;
    if (one_launch) bar = xcd_barrier_post((unsigned*)(F.ctl + CW_BAR), F.MISC + 8);


    if (ING(0, 0)) for (int rep = 0; rep < REPS(0); ++rep) {
        PTRS(); const float* const x = AIN(0); const float* const meta = AIN(1);
        LAS float* scr = (LAS float*)(F.lds + RING_OFF + wave * 16384);
        bf16* const Win_t = (bf16*)(ws + WS_WIN); bf16* const Wout_t = (bf16*)(ws + WS_WOUT); bf16* const Wgu0 = (bf16*)(ws + WS_WGU0); bf16* const Wd0 = (bf16*)(ws + WS_WD0);
        unsigned char* const Wmgu = ws + WS_WMOE_GU; unsigned char* const Wmd = ws + WS_WMOE_D;
        constexpr int I_IN = 16 * 48, I_OUT = 16 * 16, I_G0 = 16 * 44, I_D0 = 44 * 16, I_GM = 16 * 56, I_DM = 56 * 16;
        constexpr int N0 = 2 * I_IN, N1 = N0 + 2 * I_OUT, N2 = N1 + 2 * I_G0, N3 = N2 + I_D0, N4 = N3 + 16 * I_GM, N5 = N4 + 8 * I_DM;
        for (int cr = 0; cr < REPS(15); ++cr)
        for (int it = gw; it < I_IN; it += NGW) {
            if (it < N0) { const int l = it / I_IN, r = it % I_IN; cvt_item<1>(AIN(4) + (size_t)l * DM * DIN, DM, DIN, Win_t + (size_t)l * DIN * DM, 0, scr, r, lane); }
            else if (it < N1) { const int q = it - N0, l = q / I_OUT, r = q % I_OUT; cvt_item<0>(AIN(11) + (size_t)l * DM * DM, DM, DM, Wout_t + (size_t)l * DM * DM, 0, scr, r, lane); }
            else if (it < N2) { const int q = it - N1, w = q / I_G0, r = q % I_G0; cvt_item<2>(AIN(16 + w), DM, FF0, Wgu0, 128 * w, scr, r, lane); }
            else if (it < N3) { const int r = it - N2; cvt_item<0>(AIN(18), FF0, DM, Wd0, 0, scr, r, lane); }
#if 0
            else if (it < N4) { const int q = it - N3, ew = q / I_GM, r = q % I_GM, e = ew >> 1, w = ew & 1; cvt_item8<2>(AIN(20 + w) + (size_t)e * DM * FFE, DM, FFE, Wmgu, e * 2 * FFE + 128 * w, scr, r, lane, WS_GU); }
            else { const int q = it - N4, e = q / I_DM, r = q % I_DM; cvt_item8<0>(AIN(22) + (size_t)e * FFE * DM, FFE, DM, Wmd, e * DM, scr, r, lane, WS_DN); }
#endif
        }
        for (int i = blockIdx.x * NTHREADS + tid; i < LSEQ * 32; i += F.G * NTHREADS) { const int t = i >> 5, d = i & 31;
            double inv = 1.0; for (int k = 0; k < d; ++k) inv *= 0.7498942093324558273;
            const double rev = (double)t * inv * 0.15915494309189533577; const float fr = (float)(rev - __builtin_rint(rev));
            ropec[i] = __builtin_amdgcn_cosf(fr); ropes[i] = __builtin_amdgcn_sinf(fr); }
        for (int er = 0; er < REPS(16); ++er) {
        float gr[16], br[16]; load_gb16(gr, AIN(2), lane); load_gb16(br, AIN(3), lane);
        f32x4 nr[2][4];
#define EMB_ISSUE(M0) do { _Pragma("unroll") for (int q = 0; q < 2; ++q) { const int m = (M0) + q * NGW; if (m < M) { const int b = m / LSEQ, t = m % LSEQ; const float* src = t < NMETA ? meta + (size_t)t * DM : x + ((size_t)b * SEQ + (t - NMETA)) * DM; \
            _Pragma("unroll") for (int j = 0; j < 2; ++j) { nr[q][2 * j] = *(const GAS f32x4*)(src + 8 * lane + 512 * j); nr[q][2 * j + 1] = *(const GAS f32x4*)(src + 8 * lane + 512 * j + 4); } } } } while (0)
        EMB_ISSUE(gw);
        for (int m0 = gw; m0 < M; m0 += 2 * NGW) { float v[2][16];
#pragma unroll
            for (int q = 0; q < 2; ++q)
#pragma unroll
                for (int j = 0; j < 2; ++j) { const f32x4 a = nr[q][2 * j], c = nr[q][2 * j + 1];
                    v[q][8 * j + 0] = a[0]; v[q][8 * j + 1] = a[1]; v[q][8 * j + 2] = a[2]; v[q][8 * j + 3] = a[3]; v[q][8 * j + 4] = c[0]; v[q][8 * j + 5] = c[1]; v[q][8 * j + 6] = c[2]; v[q][8 * j + 7] = c[3]; }
            if (m0 + 2 * NGW < M) EMB_ISSUE(m0 + 2 * NGW);
#pragma unroll
            for (int q = 0; q < 2; ++q) { const int m = m0 + q * NGW; if (m < M) { ln16r(v[q], gr, br); store16_bf16(v[q], H + (size_t)m * DM, lane); } } }
#undef EMB_ISSUE
        }
        zero_rows_bf16(H + (size_t)M * DM, MP - M, DM, gw, NGW, lane);
        zero_rows_bf16(Vb + (size_t)M * 512, 384, 512, gw, NGW, lane);
        { typedef int i32x4v __attribute__((ext_vector_type(4)));
          i32x4v* const rt = (i32x4v*)(ws + WS_ROWINFO);
          for (int i = blockIdx.x * NTHREADS + tid; i < NEXP * MOE_CAPR / 2; i += F.G * NTHREADS) rt[i] = (i32x4v){-1, 0, -1, 0}; }
        GRID_BAR(0);
    }

    layer_body<0>(F, bar, lo, hi, lds);
    layer_body<1>(F, bar, lo, hi, lds);
#undef IN
#undef GRID_BAR
}

extern "C" void kernel_launch(void* const* d_in, const int* in_sizes, int n_in, void* d_out, int out_size, void* d_ws, size_t ws_size, hipStream_t stream) {
    static int grid = 0;
    if (grid == 0) {
        if (n_in != 23 || in_sizes[0] != MMAIN * DM || out_size != MMAIN * DM || ws_size < WS_END) { fprintf(stderr, "kernel_launch: unexpected shapes: n_in %d in0 %d out %d ws %zu (need %zu); nothing launched\n", n_in, n_in > 0 ? in_sizes[0] : -1, out_size, ws_size, (size_t)WS_END); grid = -1; return; }
        int dev = 0, cus = 0, per_cu = 0;
        if (hipGetDevice(&dev) != hipSuccess || hipDeviceGetAttribute(&cus, hipDeviceAttributeMultiprocessorCount, dev) != hipSuccess) { grid = -1; return; }
        if (hipFuncSetAttribute((const void*)hybrid_fwd, hipFuncAttributeMaxDynamicSharedMemorySize, LDS_BYTES) != hipSuccess) { fprintf(stderr, "kernel_launch: hipFuncSetAttribute failed\n"); grid = -1; return; }
        if (hipOccupancyMaxActiveBlocksPerMultiprocessor(&per_cu, (const void*)hybrid_fwd, NTHREADS, LDS_BYTES) != hipSuccess || per_cu < 1) fprintf(stderr, "kernel_launch: occupancy query reports %d\n", per_cu);
        (void)hipGetLastError();
        grid = cus;
    }
    if (grid < 0) return;
    if (hipMemsetAsync((char*)d_ws + WS_CTL, 0, CTL_ZERO_BYTES + STATS_BYTES, stream) != hipSuccess) return;
    Args a{};
    for (int i = 0; i < 23; ++i) a.in[i] = (const float*)d_in[i];
    a.out = (float*)d_out; a.ws = (unsigned char*)d_ws;
#if MK_PER_PHASE
    for (int p = 0; p < NPHASES; ++p) { a.ph_lo = p; a.ph_hi = p + 1; hipLaunchKernelGGL(hybrid_fwd, dim3(grid), dim3(NTHREADS), LDS_BYTES, stream, a); }
#else
    a.ph_lo = 0; a.ph_hi = NPHASES;
    hipLaunchKernelGGL(hybrid_fwd, dim3(grid), dim3(NTHREADS), LDS_BYTES, stream, a);
#endif
}
```
